# Optimizing an MI355X kernel written in HIP

```python
import math
import jax
import jax.numpy as jnp
from jax import lax
import numpy as np

D_MODEL = 1024
BATCH = 4
SEQ = 8192
DEPTH = 1

CTX_LEN = 256
GRID_W = 64
EPS = 1e-6
N_MOD = 9
D_FF = 2816
GLA_HEADS = 4
GLA_DK = D_MODEL // 8
GLA_DV = D_MODEL // 4
GLA_RANK = 16
GLA_TAU = 16.0
GLA_CHUNK = 64
DIFF_HEADS = 8
DIFF_DH = D_MODEL // 16
Q_BLOCK = 128
ROPE_BASE = 10000.0
GLA_QK = GLA_HEADS * GLA_DK
GLA_V = GLA_HEADS * GLA_DV
DIFF_QK = DIFF_HEADS * 2 * DIFF_DH
DIFF_V = DIFF_HEADS * 2 * DIFF_DH
IN_SPLITS = (GLA_QK, GLA_QK, GLA_V, GLA_V, 2 * GLA_RANK, DIFF_QK, DIFF_QK, DIFF_V, 2 * D_MODEL)
IN_COLS = 2 * GLA_QK + 2 * GLA_V + 2 * GLA_RANK + 2 * DIFF_QK + DIFF_V + 2 * D_MODEL

kernel_name = 'hybrid_gla_diffattn_macaron_dit'


def _rmsnorm(x, g):
    xf = x.astype(jnp.float32)
    y = xf * lax.rsqrt(jnp.mean(xf * xf, axis=-1, keepdims=True) + EPS)
    return (y * g.astype(jnp.float32)).astype(x.dtype)


def _modnorm(h, g, shift, scale):
    return _rmsnorm(h, g) * (1.0 + scale) + shift


def _swiglu(h, w1, w3, w2):
    return (jax.nn.silu(h @ w1) * (h @ w3)) @ w2


def _split_cols(p):
    idx = np.cumsum(IN_SPLITS)[:-1].tolist()
    return jnp.split(p, idx, axis=-1)


def _axial_rope(t, row, col):
    half = DIFF_DH // 2
    quarter = half // 2
    inv = ROPE_BASE ** (-np.arange(quarter, dtype=np.float32) / quarter)

    def rot(u, pos):
        ang = pos.astype(jnp.float32)[:, None] * inv[None, :]
        cos = jnp.cos(ang)[None, :, None, None, :].astype(u.dtype)
        sin = jnp.sin(ang)[None, :, None, None, :].astype(u.dtype)
        u1, u2 = u[..., :quarter], u[..., quarter:]
        return jnp.concatenate([u1 * cos - u2 * sin, u2 * cos + u1 * sin], axis=-1)

    return jnp.concatenate([rot(t[..., :half], row), rot(t[..., half:], col)], axis=-1)


def _gla_scan(q, k, v, logf, s0):
    b_, L, h, _ = q.shape
    dv = v.shape[-1]
    n = L // GLA_CHUNK

    def chunks(t):
        return t.astype(jnp.float32).reshape(b_, n, GLA_CHUNK, h, t.shape[-1]).transpose(1, 0, 3, 2, 4)

    tril = jnp.tril(jnp.ones((GLA_CHUNK, GLA_CHUNK), dtype=bool))[:, :, None]

    def step(state, inp):
        qc, kc, vc, gc = inp
        cum = jnp.cumsum(gc, axis=2)
        o_inter = jnp.einsum('bhtd,bhde->bhte', qc * jnp.exp(cum), state)
        rel = jnp.where(tril, cum[:, :, :, None, :] - cum[:, :, None, :, :], -jnp.inf)
        attn = jnp.einsum('bhtd,bhsd,bhtsd->bhts', qc, kc, jnp.exp(rel))
        o_intra = jnp.einsum('bhts,bhse->bhte', attn, vc)
        last = cum[:, :, -1:, :]
        new_state = (jnp.exp(last[:, :, 0, :])[..., None] * state
                     + jnp.einsum('bhsd,bhse->bhde', kc * jnp.exp(last - cum), vc))
        return new_state, o_inter + o_intra

    state, o = lax.scan(step, s0, (chunks(q), chunks(k), chunks(v), chunks(logf)))
    o = o.transpose(1, 0, 3, 2, 4).reshape(b_, L, h, dv)
    return o, state


def _gla_direction(q, k, v, lr, w2, bias, s0, reverse):
    logf = jax.nn.log_sigmoid((lr @ w2 + bias).astype(jnp.float32)) / GLA_TAU
    logf = logf.reshape(q.shape)
    if reverse:
        q, k, v, logf = jnp.flip(q, 1), jnp.flip(k, 1), jnp.flip(v, 1), jnp.flip(logf, 1)
    o, s = _gla_scan(q, k, v, logf, s0)
    if reverse:
        o = jnp.flip(o, 1)
    return o.astype(v.dtype), s


def _gla_heads(q, k, v, L):
    b_ = q.shape[0]
    return (q.reshape(b_, L, GLA_HEADS, GLA_DK) * (GLA_DK ** -0.5),
            k.reshape(b_, L, GLA_HEADS, GLA_DK),
            v.reshape(b_, L, GLA_HEADS, GLA_DV))


def _gla_head_out(o, gate, norm_g, w_branch):
    b_, L = o.shape[:2]
    y = _rmsnorm(o, norm_g.reshape(GLA_HEADS, GLA_DV)).reshape(b_, L, GLA_V)
    return (y * jax.nn.silu(gate)) @ w_branch


def _diff_block(q, k, v, lam):
    s = jnp.einsum('bqhcd,bkhcd->bhcqk', q, k).astype(jnp.float32) * (DIFF_DH ** -0.5)
    p = jax.nn.softmax(s, axis=-1)
    a = p[:, :, 0] - lam * p[:, :, 1]
    return jnp.einsum('bhqk,bkhe->bqhe', a.astype(v.dtype), v)


def _diff_latent(q, k, v, lam):
    b_, L = q.shape[:2]
    nb = L // Q_BLOCK
    qb = q.reshape((b_, nb, Q_BLOCK) + q.shape[2:]).swapaxes(0, 1)
    o = lax.map(lambda qq: _diff_block(qq, k, v, lam), qb)
    return o.swapaxes(0, 1).reshape((b_, L) + o.shape[3:])


def _diff_head_out(o, norm_g, lam_init, w_branch):
    b_, L = o.shape[:2]
    y = _rmsnorm(o, norm_g.reshape(DIFF_HEADS, 2 * DIFF_DH)).reshape(b_, L, DIFF_V)
    return (y * (1.0 - lam_init)) @ w_branch


def setup_inputs(seed: int = 0) -> dict:
    key = jax.random.key(seed)
    ks = jax.random.split(key, 30)
    f32 = jnp.float32

    def nrm(k, shape, scale):
        return jax.random.normal(k, shape, f32) * scale

    def gain(k, shape):
        return 1.0 + 0.02 * jax.random.normal(k, shape, f32)

    L = DEPTH
    return {
        'x': nrm(ks[0], (BATCH, SEQ, D_MODEL), 1.0),
        'c': nrm(ks[1], (BATCH, D_MODEL), 1.0),
        'ctx': nrm(ks[2], (BATCH, CTX_LEN, D_MODEL), 1.0),
        'c_ctx': nrm(ks[3], (D_MODEL,), 1.0),
        'w_ada': nrm(ks[4], (L, D_MODEL, N_MOD * D_MODEL), 0.5 * D_MODEL ** -0.5),
        'b_ada': nrm(ks[5], (L, N_MOD * D_MODEL), 0.02),
        'ffn1_norm': gain(ks[6], (L, D_MODEL)),
        'ffn1_w1': nrm(ks[7], (L, D_MODEL, D_FF), D_MODEL ** -0.5),
        'ffn1_w3': nrm(ks[8], (L, D_MODEL, D_FF), D_MODEL ** -0.5),
        'ffn1_w2': nrm(ks[9], (L, D_FF, D_MODEL), D_FF ** -0.5),
        'mix_norm': gain(ks[10], (L, D_MODEL)),
        'w_in': nrm(ks[11], (L, D_MODEL, IN_COLS), D_MODEL ** -0.5),
        'gla_gate_w2': nrm(ks[12], (L, 2, GLA_RANK, GLA_QK), GLA_RANK ** -0.5),
        'gla_gate_b': nrm(ks[13], (L, 2, GLA_QK), 0.1),
        'gla_out_norm': gain(ks[14], (L, GLA_V)),
        'diff_lambda': nrm(ks[15], (L, 4, DIFF_DH), 0.1),
        'diff_out_norm': gain(ks[16], (L, DIFF_V)),
        'w_branch_gla': nrm(ks[17], (L, GLA_V, D_MODEL), GLA_V ** -0.5),
        'w_branch_diff': nrm(ks[18], (L, DIFF_V, D_MODEL), DIFF_V ** -0.5),
        'w_out': nrm(ks[19], (L, D_MODEL, D_MODEL), D_MODEL ** -0.5),
        'ffn2_norm': gain(ks[20], (L, D_MODEL)),
        'ffn2_w1': nrm(ks[21], (L, D_MODEL, D_FF), D_MODEL ** -0.5),
        'ffn2_w3': nrm(ks[22], (L, D_MODEL, D_FF), D_MODEL ** -0.5),
        'ffn2_w2': nrm(ks[23], (L, D_FF, D_MODEL), D_FF ** -0.5),
        'final_norm': gain(ks[24], (D_MODEL,)),
    }


def reference(x, c, ctx, c_ctx, w_ada, b_ada, ffn1_norm, ffn1_w1, ffn1_w3, ffn1_w2, mix_norm, w_in,
              gla_gate_w2, gla_gate_b, gla_out_norm, diff_lambda, diff_out_norm, w_branch_gla,
              w_branch_diff, w_out, ffn2_norm, ffn2_w1, ffn2_w3, ffn2_w2, final_norm):
    b_, seq, _ = x.shape
    n_ctx = ctx.shape[1]
    rows = seq // GRID_W
    t = jnp.arange(rows * GRID_W, dtype=jnp.int32)
    t_row, t_col = t // GRID_W, t % GRID_W
    s0 = jnp.zeros((b_, GLA_HEADS, GLA_DK, GLA_DV), jnp.float32)
    xl, xc = x, ctx
    for i in range(DEPTH):
        last = i == DEPTH - 1
        lam_init = 0.8 - 0.6 * math.exp(-0.3 * i)
        ml = jnp.split((jax.nn.silu(c) @ w_ada[i] + b_ada[i])[:, None, :], N_MOD, axis=-1)
        mc = jnp.split((jax.nn.silu(c_ctx) @ w_ada[i] + b_ada[i])[None, None, :], N_MOD, axis=-1)

        xl = xl + 0.5 * ml[2] * _swiglu(_modnorm(xl, ffn1_norm[i], ml[0], ml[1]), ffn1_w1[i], ffn1_w3[i], ffn1_w2[i])
        xc = xc + 0.5 * mc[2] * _swiglu(_modnorm(xc, ffn1_norm[i], mc[0], mc[1]), ffn1_w1[i], ffn1_w3[i], ffn1_w2[i])

        gq_l, gk_l, gv_l, gg_l, lr_l, dq_l, dk_l, dv_l, mg_l = _split_cols(
            _modnorm(xl, mix_norm[i], ml[3], ml[4]) @ w_in[i])
        gq_c, gk_c, gv_c, gg_c, lr_c, dq_c, dk_c, dv_c, mg_c = _split_cols(
            _modnorm(xc, mix_norm[i], mc[3], mc[4]) @ w_in[i])

        gq_c, gk_c, gv_c = _gla_heads(gq_c, gk_c, gv_c, n_ctx)
        gq_l, gk_l, gv_l = _gla_heads(gq_l, gk_l, gv_l, seq)
        oc_f, sc_f = _gla_direction(gq_c, gk_c, gv_c, lr_c[..., :GLA_RANK], gla_gate_w2[i, 0], gla_gate_b[i, 0], s0, False)
        oc_b, sc_b = _gla_direction(gq_c, gk_c, gv_c, lr_c[..., GLA_RANK:], gla_gate_w2[i, 1], gla_gate_b[i, 1], s0, True)
        ol_f, _ = _gla_direction(gq_l, gk_l, gv_l, lr_l[..., :GLA_RANK], gla_gate_w2[i, 0], gla_gate_b[i, 0], sc_f, False)
        ol_b, _ = _gla_direction(gq_l, gk_l, gv_l, lr_l[..., GLA_RANK:], gla_gate_w2[i, 1], gla_gate_b[i, 1], sc_b, True)
        y_gla_l = _gla_head_out(ol_f + ol_b, gg_l, gla_out_norm[i], w_branch_gla[i])

        lam = (jnp.exp(jnp.sum(diff_lambda[i, 0] * diff_lambda[i, 1]))
               - jnp.exp(jnp.sum(diff_lambda[i, 2] * diff_lambda[i, 3])) + lam_init)
        dq_l = _axial_rope(dq_l.reshape(b_, seq, DIFF_HEADS, 2, DIFF_DH), t_row, t_col)
        dk_l = _axial_rope(dk_l.reshape(b_, seq, DIFF_HEADS, 2, DIFF_DH), t_row, t_col)
        dv_l = dv_l.reshape(b_, seq, DIFF_HEADS, 2 * DIFF_DH)
        dk_c = dk_c.reshape(b_, n_ctx, DIFF_HEADS, 2, DIFF_DH)
        dv_c = dv_c.reshape(b_, n_ctx, DIFF_HEADS, 2 * DIFF_DH)
        k_all = jnp.concatenate([dk_c, dk_l], axis=1)
        v_all = jnp.concatenate([dv_c, dv_l], axis=1)
        y_diff_l = _diff_head_out(_diff_latent(dq_l, k_all, v_all, lam), diff_out_norm[i], lam_init, w_branch_diff[i])

        ga_l, gb_l = jnp.split(jax.nn.sigmoid(mg_l), 2, axis=-1)
        xl = xl + ml[5] * ((ga_l * y_gla_l + gb_l * y_diff_l) @ w_out[i])

        if not last:
            y_gla_c = _gla_head_out(oc_f + oc_b, gg_c, gla_out_norm[i], w_branch_gla[i])
            od_c = _diff_block(dq_c.reshape(b_, n_ctx, DIFF_HEADS, 2, DIFF_DH), dk_c, dv_c, lam)
            y_diff_c = _diff_head_out(od_c, diff_out_norm[i], lam_init, w_branch_diff[i])
            ga_c, gb_c = jnp.split(jax.nn.sigmoid(mg_c), 2, axis=-1)
            xc = xc + mc[5] * ((ga_c * y_gla_c + gb_c * y_diff_c) @ w_out[i])
            xc = xc + 0.5 * mc[8] * _swiglu(_modnorm(xc, ffn2_norm[i], mc[6], mc[7]), ffn2_w1[i], ffn2_w3[i], ffn2_w2[i])

        xl = xl + 0.5 * ml[8] * _swiglu(_modnorm(xl, ffn2_norm[i], ml[6], ml[7]), ffn2_w1[i], ffn2_w3[i], ffn2_w2[i])
    return _rmsnorm(xl, final_norm)
```

```cpp
#define MK_ONE_LAUNCH 1
#define ATT_PLAN 2
#define ATT_SLICE 2
#define SPLITK_DOWN1 1
#include <hip/hip_runtime.h>
#include <hip/hip_cooperative_groups.h>
#include <cstdio>
#include <cstdint>
namespace cg = cooperative_groups;
namespace pg8 {
#define PG8_LAS __attribute__((address_space(3)))
typedef unsigned short bf16_t;
typedef short bf16x8 __attribute__((ext_vector_type(8)));
typedef float f32x4 __attribute__((ext_vector_type(4)));
typedef unsigned u32x4 __attribute__((ext_vector_type(4)));
constexpr int BM = 256, BK = 64, HALF = 128, HTB = HALF * BK * 2  , STAGE_BYTES = 8 * HTB, NXCD = 8, WGM = 8;

__host__ __device__ __forceinline__ int lds_byte(int r, int c) { const int st = (r >> 4) * 2 + (c >> 5), rr = r & 15, cc = c & 31, ob = rr * 64 + cc * 2; return st * 1024 + (ob ^ (((ob >> 9) & 1) << 5)); }
__host__ __device__ __forceinline__ void stage_rc(int b, int& R, int& C) { const int st = b / 1024, sb = b % 1024, swz = sb ^ (((sb >> 9) & 1) << 5); R = (st >> 1) * 16 + swz / 64; C = (st & 1) * 32 + (swz % 64) / 2; }
__host__ __device__ __forceinline__ int perm32(int rho) { const int n = rho >> 4, i = rho & 15; return 8 * (i >> 2) + 4 * n + (i & 3); }

struct Unit { int pm, pn, kb, nt; };
struct Gemm { const bf16_t* A; const bf16_t* Bt; int M, N, K; };

struct StaticOrder {
    static constexpr bool SPLITK = false;
    int nM, nN, nwg, G, c;
    __host__ __device__ void init(int M, int N, int G_, int c_) { nM = M / BM; nN = N / BM; nwg = nM * nN; G = G_; c = c_; }
    __host__ __device__ bool next(int i, Unit& u) const {
        const long L = (long)i * G + c; if (L >= nwg) return false;
        int wgid = (int)L; { const int q = nwg / NXCD, r = nwg % NXCD, xcd = wgid % NXCD, off = wgid / NXCD; wgid = (xcd < r ? xcd * (q + 1) : r * (q + 1) + (xcd - r) * q) + off; }
        const int nig = WGM * nN, gid = wgid / nig, fm = gid * WGM, gsz = (nM - fm) < WGM ? (nM - fm) : WGM;
        u.pm = fm + ((wgid % nig) % gsz); u.pn = (wgid % nig) / gsz; return true;
    }
    __device__ __forceinline__ void a_ready(const Unit&) const {}
    __device__ __forceinline__ void done(const Unit&) const {}
};

__device__ __forceinline__ unsigned cvt_pk_bf16(float lo, float hi) { unsigned r; asm volatile("v_cvt_pk_bf16_f32 %0, %1, %2" : "=v"(r) : "v"(lo), "v"(hi)); return r; }
typedef float f32x2 __attribute__((ext_vector_type(2)));
template <class Epi, class Sched, bool ALIGN_EPI = false, bool SP2 = false>
__device__ __forceinline__ void gemm_phase(PG8_LAS unsigned char* lds, const Gemm g, const Sched& S, const Epi& E) {
    const int tid = threadIdx.x, wid = __builtin_amdgcn_readfirstlane(tid >> 6), lane = tid & 63, wr = wid >> 2, wc = wid & 3, fr = lane & 15, fq = lane >> 4;
    const int K = g.K; int nt = K / BK;
    unsigned voffA[2], voffB[2];
#pragma unroll
    for (int i = 0; i < 2; ++i) { int R, C; stage_rc(tid * 16 + i * 8192, R, C); const int Rb = Epi::PERM ? ((R & ~31) + perm32(R & 31)) : R;
        voffA[i] = (unsigned)(R * K + C) * 2u; voffB[i] = (unsigned)(Rb * K + C) * 2u; }
    const size_t kstep = (size_t)(BK * 2);
    const size_t hstep = (size_t)HALF * K * 2;
    const size_t tstep = 2 * hstep;
    const unsigned ldsw = (unsigned)wid * 1024u;
    const int aoff = lds_byte(wr * 64 + fr, fq * 8), boff = lds_byte(wc * 32 + fr, fq * 8);
#define PG8_SA(b, h) (((b) * 2 + (h)) * HTB)
#define PG8_SB(b, h) ((4 + (b) * 2 + (h)) * HTB)
#define PG8_STAGE(bufoff, gbase, voff) do { _Pragma("unroll") for (int _i = 0; _i < 2; ++_i) \
        __builtin_amdgcn_global_load_lds((const unsigned*)((const char*)(gbase) + (voff)[_i]), (PG8_LAS unsigned*)(lds + (bufoff) + ldsw + _i * 8192), 16, 0, 0); } while (0)
#define PG8_LDA(dst, b, h) do { _Pragma("unroll") for (int m = 0; m < 4; ++m) _Pragma("unroll") for (int k = 0; k < 2; ++k) dst[m][k] = *(const PG8_LAS bf16x8*)(lds + PG8_SA(b, h) + aoff + m * 2048 + k * 1024); } while (0)
#define PG8_LDB(dst, b, h) do { _Pragma("unroll") for (int n = 0; n < 2; ++n) _Pragma("unroll") for (int k = 0; k < 2; ++k) dst[n][k] = *(const PG8_LAS bf16x8*)(lds + PG8_SB(b, h) + boff + n * 2048 + k * 1024); } while (0)
#define PG8_MMA(ai, bj, At, Bt) do { __builtin_amdgcn_s_setprio(1); _Pragma("unroll") for (int m = 0; m < 4; ++m) _Pragma("unroll") for (int n = 0; n < 2; ++n) _Pragma("unroll") for (int k = 0; k < 2; ++k) \
        acc[ai][bj][m][n] = __builtin_amdgcn_mfma_f32_16x16x32_bf16(Bt[n][k], At[m][k], acc[ai][bj][m][n], 0, 0, 0); __builtin_amdgcn_s_setprio(0); } while (0)
#define PG8_WAIT_V(n) asm volatile("s_waitcnt vmcnt(" #n ")" ::: "memory")
#define PG8_WAIT_L(n) asm volatile("s_waitcnt lgkmcnt(" #n ")" ::: "memory")
#define PG8_BAR __builtin_amdgcn_s_barrier()
#define PG8_SCHED __builtin_amdgcn_sched_barrier(0)
    Unit cur, nxt; int ui = 0;
    if (!S.next(0, cur)) return;
    if constexpr (Sched::SPLITK) nt = cur.nt;
    f32x4 acc[2][2][4][2];
#pragma unroll
    for (int a = 0; a < 2; ++a)
#pragma unroll
        for (int b = 0; b < 2; ++b)
#pragma unroll
            for (int m = 0; m < 4; ++m)
#pragma unroll
                for (int n = 0; n < 2; ++n) acc[a][b][m][n] = (f32x4){0.f, 0.f, 0.f, 0.f};
    bf16x8 At[4][2], B0[2][2], B1[2][2];
    const char* cA = (const char*)g.A + (size_t)cur.pm * tstep; const char* cB = (const char*)g.Bt + (size_t)cur.pn * tstep;
    if constexpr (Sched::SPLITK) { cA += (size_t)cur.kb * kstep; cB += (size_t)cur.kb * kstep; }
    S.a_ready(cur);
    if constexpr (SP2) {
        PG8_STAGE(PG8_SB(0, 0), cB, voffB); PG8_STAGE(PG8_SB(0, 1), cB + hstep, voffB); PG8_STAGE(PG8_SA(0, 0), cA, voffA); PG8_STAGE(PG8_SA(0, 1), cA + hstep, voffA);
        if (wr == 1) PG8_BAR;
        PG8_WAIT_V(2); PG8_BAR;
        PG8_STAGE(PG8_SB(1, 0), cB + kstep, voffB); PG8_STAGE(PG8_SA(1, 0), cA + kstep, voffA); PG8_STAGE(PG8_SB(1, 1), cB + hstep + kstep, voffB);
        PG8_WAIT_V(6); PG8_BAR;
    } else {
        PG8_STAGE(PG8_SB(0, 0), cB, voffB); PG8_STAGE(PG8_SA(0, 0), cA, voffA); PG8_STAGE(PG8_SB(0, 1), cB + hstep, voffB); PG8_STAGE(PG8_SA(0, 1), cA + hstep, voffA);
        if (wr == 1) PG8_BAR;
        PG8_WAIT_V(4); PG8_BAR;
        PG8_STAGE(PG8_SB(1, 0), cB + kstep, voffB); PG8_STAGE(PG8_SA(1, 0), cA + kstep, voffA); PG8_STAGE(PG8_SB(1, 1), cB + hstep + kstep, voffB);
        PG8_WAIT_V(6); PG8_BAR;
    }
    for (;;) {
        const bool has_next = S.next(ui + 1, nxt);
        const char* nA = has_next ? (const char*)g.A + (size_t)nxt.pm * tstep : cA; const char* nB = has_next ? (const char*)g.Bt + (size_t)nxt.pn * tstep : cB;
        if constexpr (Sched::SPLITK) { if (has_next) { nA += (size_t)nxt.kb * kstep; nB += (size_t)nxt.kb * kstep; } }
        for (int t = 0; t < nt; t += 2) {
            const bool last = (t == nt - 2);
            const char* a1 = cA + (size_t)(t + 1) * kstep;
            const char* a2 = last ? nA : cA + (size_t)(t + 2) * kstep; const char* b2 = last ? nB : cB + (size_t)(t + 2) * kstep;
            const char* a3 = a2 + kstep; const char* b3 = b2 + kstep;
            if (last && has_next) S.a_ready(nxt);
            if constexpr (SP2) {
            PG8_LDB(B0, 0, 0); PG8_LDB(B1, 0, 1); PG8_SCHED; PG8_LDA(At, 0, 0); PG8_STAGE(PG8_SA(1, 1), a1 + hstep, voffA);
            PG8_WAIT_V(8); PG8_WAIT_L(0); PG8_BAR; PG8_MMA(0, 0, At, B0); PG8_MMA(0, 1, At, B1); PG8_BAR; PG8_SCHED;
            PG8_LDA(At, 0, 1); PG8_STAGE(PG8_SB(0, 0), b2, voffB); PG8_STAGE(PG8_SB(0, 1), b2 + hstep, voffB); PG8_STAGE(PG8_SA(0, 0), a2, voffA);
            PG8_WAIT_V(8); PG8_WAIT_L(0); PG8_BAR; PG8_MMA(1, 0, At, B0); PG8_MMA(1, 1, At, B1); PG8_BAR; PG8_SCHED;
            PG8_LDB(B0, 1, 0); PG8_LDB(B1, 1, 1); PG8_SCHED; PG8_LDA(At, 1, 0); PG8_STAGE(PG8_SA(0, 1), a2 + hstep, voffA);
            PG8_WAIT_V(8); PG8_WAIT_L(0); PG8_BAR; PG8_MMA(0, 0, At, B0); PG8_MMA(0, 1, At, B1); PG8_BAR; PG8_SCHED;
            PG8_LDA(At, 1, 1); PG8_STAGE(PG8_SB(1, 0), b3, voffB); PG8_STAGE(PG8_SB(1, 1), b3 + hstep, voffB); PG8_STAGE(PG8_SA(1, 0), a3, voffA);
            PG8_WAIT_V(8); PG8_WAIT_L(0); PG8_BAR; PG8_MMA(1, 0, At, B0); PG8_MMA(1, 1, At, B1); PG8_BAR; PG8_SCHED;
            } else {
            PG8_LDB(B0, 0, 0); PG8_SCHED; PG8_LDA(At, 0, 0); PG8_STAGE(PG8_SA(1, 1), a1 + hstep, voffA);
            PG8_WAIT_L(8); PG8_BAR; PG8_WAIT_L(0); PG8_MMA(0, 0, At, B0); PG8_BAR; PG8_SCHED;
            PG8_LDB(B1, 0, 1); PG8_STAGE(PG8_SB(0, 0), b2, voffB);
            PG8_BAR; PG8_WAIT_L(0); PG8_MMA(0, 1, At, B1); PG8_BAR;
            PG8_LDA(At, 0, 1); PG8_STAGE(PG8_SA(0, 0), a2, voffA);
            PG8_BAR; PG8_WAIT_L(0); PG8_MMA(1, 0, At, B0); PG8_BAR; PG8_SCHED;
            PG8_STAGE(PG8_SB(0, 1), b2 + hstep, voffB);
            PG8_WAIT_V(6); PG8_BAR; PG8_MMA(1, 1, At, B1); PG8_BAR;
            PG8_LDB(B0, 1, 0); PG8_SCHED; PG8_LDA(At, 1, 0); PG8_STAGE(PG8_SA(0, 1), a2 + hstep, voffA);
            PG8_WAIT_L(8); PG8_BAR; PG8_WAIT_L(0); PG8_MMA(0, 0, At, B0); PG8_BAR; PG8_SCHED;
            PG8_LDB(B1, 1, 1); PG8_STAGE(PG8_SB(1, 0), b3, voffB);
            PG8_BAR; PG8_WAIT_L(0); PG8_MMA(0, 1, At, B1); PG8_BAR;
            PG8_LDA(At, 1, 1); PG8_STAGE(PG8_SA(1, 0), a3, voffA);
            PG8_BAR; PG8_WAIT_L(0); PG8_MMA(1, 0, At, B0); PG8_BAR; PG8_SCHED;
            PG8_STAGE(PG8_SB(1, 1), b3 + hstep, voffB);
            PG8_WAIT_V(6); PG8_BAR; PG8_MMA(1, 1, At, B1); PG8_BAR;
            }
        }
        if constexpr (ALIGN_EPI) { if (wr == 0) PG8_BAR; }
        if constexpr (!Epi::AFTER_DRAIN) { E(acc, cur, wr, wc, fr, fq); S.done(cur); }
        if (!has_next) break;
#pragma unroll
        for (int a = 0; a < 2; ++a)
#pragma unroll
            for (int b = 0; b < 2; ++b)
#pragma unroll
                for (int m = 0; m < 4; ++m)
#pragma unroll
                    for (int n = 0; n < 2; ++n) acc[a][b][m][n] = (f32x4){0.f, 0.f, 0.f, 0.f};
        cur = nxt; cA = nA; cB = nB; ++ui;
        if constexpr (Sched::SPLITK) nt = cur.nt;
        if constexpr (ALIGN_EPI) { if (wr == 1) PG8_BAR; }
    }
    PG8_WAIT_V(0);
    if constexpr (!ALIGN_EPI) { if (wr == 0) PG8_BAR; }
    PG8_BAR;
    if constexpr (Epi::AFTER_DRAIN) { E.fused(acc, cur, wr, wc, fr, fq, lds, wid, lane); S.done(cur); }
#undef PG8_SA
#undef PG8_SB
#undef PG8_STAGE
#undef PG8_LDA
#undef PG8_LDB
#undef PG8_MMA
#undef PG8_WAIT_V
#undef PG8_WAIT_L
#undef PG8_BAR
#undef PG8_SCHED
}
}

#define LAS __attribute__((address_space(3)))
typedef unsigned short bf16_t;
typedef short bf16x8 __attribute__((ext_vector_type(8)));
typedef short s16x4 __attribute__((ext_vector_type(4)));
typedef float f32x4 __attribute__((ext_vector_type(4)));
typedef float f32x16 __attribute__((ext_vector_type(16)));
typedef unsigned u32x4 __attribute__((ext_vector_type(4)));
typedef unsigned u32x2 __attribute__((ext_vector_type(2)));

constexpr int DM = 1024, NB = 4, SEQL = 8192, NCTX = 256, DFF = 2816;
constexpr int LROWS = NB * SEQL, CROWS = NB * NCTX, MROWS = LROWS + CROWS;
constexpr int NMODC = 9 * DM;
constexpr float EPSN = 1e-6f;
constexpr int NWIN_A = 3328, NWIN_B = 5120;
constexpr int NCH = 132;
constexpr float QSCALE_GLA = 0.08838834764831845f;
constexpr float C2ATT = 0.125f * 1.4426950408889634f;
constexpr float LAM_INIT = 0.2f;

constexpr size_t MiB = 1u << 20;
constexpr size_t WS_CTL = 0;
constexpr size_t CTL_MOD = 0;
constexpr size_t CTL_LAM = 256 * 1024;
constexpr size_t CTL_ROPE = 320 * 1024;
constexpr size_t CTL_BAR = 512 * 1024;
constexpr size_t WS_W = 1 * MiB;
constexpr size_t W_WINA = WS_W;
constexpr size_t W_WINB = W_WINA + (size_t)NWIN_A * DM * 2;
constexpr size_t W_WBG = W_WINB + (size_t)NWIN_B * DM * 2;
constexpr size_t W_WBD = W_WBG + (size_t)DM * DM * 2;
constexpr size_t W_WOUT = W_WBD + (size_t)DM * DM * 2;
constexpr size_t W_W13B = W_WOUT + (size_t)DM * DM * 2;
constexpr size_t W_W2B = W_W13B + (size_t)2 * DFF * DM * 2;
constexpr size_t W_W13A = W_W2B + (size_t)DM * DFF * 2;
constexpr size_t W_W2A = W_W13A + (size_t)2 * DFF * DM * 2;
constexpr size_t WS_H = W_W2A + (size_t)DM * DFF * 2;
static_assert(WS_H == 1 * MiB + 58195968, "weights");
constexpr size_t WS_GG = WS_H + (size_t)MROWS * DM * 2;
constexpr size_t WS_R = WS_GG + (size_t)LROWS * DM * 2;
constexpr size_t R_U = WS_R;
constexpr size_t R_XC1 = WS_R + (size_t)MROWS * DFF * 2;
constexpr size_t R_GQ = WS_R;
constexpr size_t R_GK = WS_R + 32 * MiB;
constexpr size_t R_GV = WS_R + 65 * MiB;
constexpr size_t R_LR = WS_R + 131 * MiB;
constexpr size_t R_DEC = WS_R + 136 * MiB;
constexpr size_t R_S = WS_R + 186 * MiB;
constexpr size_t R_DQ = WS_R;
constexpr size_t R_DK = WS_R + 64 * MiB;
constexpr size_t R_DV = WS_R + 130 * MiB;
constexpr size_t R_GA = WS_R + 196 * MiB;
constexpr size_t R_GB = WS_R + 260 * MiB;
constexpr size_t WS_END = WS_R + 324 * MiB;
static_assert(R_XC1 + 4 * MiB <= R_S && R_XC1 >= R_DEC + 2 * MiB, "XC1 placement");
static_assert(WS_END <= 512 * MiB, "workspace must fit 512 MiB");

#ifndef ATT_PLAN
#define ATT_PLAN 2
#endif
#ifndef ATT_WARM
#define ATT_WARM 0
#endif
#ifndef ATT_FAST
#define ATT_FAST 1
#endif
#ifndef SPLITK_DOWN1
#define SPLITK_DOWN1 0
#endif
#ifndef ATT_SLICE
#define ATT_SLICE 0
#endif
#ifndef SEAM0_CG
#define SEAM0_CG 1
#endif
#ifndef ATT_FENCE3
#define ATT_FENCE3 1
#endif
#ifndef ATT_ASM
#define ATT_ASM 0
#endif
#ifdef ATT_XVALU
#define ATT_EXTRA_VALU(s0, s1) { float dm = 0.f; _Pragma("unroll") for (int i = 0; i < 16; ++i) { dm += __builtin_amdgcn_exp2f(s0[i] * 0.5f) + __builtin_amdgcn_exp2f(s1[i] * 0.5f); } asm volatile("" :: "v"(dm)); }
#else
#define ATT_EXTRA_VALU(s0, s1)
#endif
constexpr int LDS_BYTES = 147456 + 64;
constexpr int LDS_BARST = 147456;

__device__ __forceinline__ float bf2f(unsigned short u) { return __uint_as_float(((unsigned)u) << 16); }
__device__ __forceinline__ float bflo(unsigned u) { return __uint_as_float(u << 16); }
__device__ __forceinline__ float bfhi(unsigned u) { return __uint_as_float(u & 0xffff0000u); }
__device__ __forceinline__ unsigned short f2bf(float f) { unsigned u = __float_as_uint(f); return (unsigned short)((u + 0x7fffu + ((u >> 16) & 1u)) >> 16); }
typedef float f32x2_t __attribute__((ext_vector_type(2))); typedef __bf16 bf16x2_t __attribute__((ext_vector_type(2)));
__device__ __forceinline__ unsigned pk2(float lo, float hi) { f32x2_t v = {lo, hi}; bf16x2_t b = __builtin_convertvector(v, bf16x2_t); return __builtin_bit_cast(unsigned, b); }
__device__ __forceinline__ float wave_sum(float v) {
#pragma unroll
    for (int o = 1; o < 64; o <<= 1) v += __shfl_xor(v, o);
    return v;
}
__device__ __forceinline__ float max3f(float a, float b, float c) { float r; asm("v_max3_f32 %0, %1, %2, %3" : "=v"(r) : "v"(a), "v"(b), "v"(c)); return r; }
__device__ __forceinline__ float fadd1(float a, float b, unsigned after) { float r; asm("v_add_f32_e32 %0, %1, %2" : "=v"(r) : "v"(a), "v"(b), "v"(after)); return r; }
__device__ __forceinline__ float fast_sigmoid(float a) { return __builtin_amdgcn_rcpf(1.f + __expf(-a)); }
__device__ __forceinline__ float fast_silu(float a) { return a * fast_sigmoid(a); }
__device__ __forceinline__ float logsigmoid_f(float z) { return fminf(z, 0.f) - __logf(1.f + __expf(-fabsf(z))); }
__device__ __forceinline__ s16x4 vtr(const LAS unsigned char* p) {
    return __builtin_bit_cast(s16x4, __builtin_amdgcn_ds_read_tr16_b64_v4i16((LAS s16x4*)p));
}
__device__ __forceinline__ bf16x8 cat8(s16x4 a, s16x4 b) { return (bf16x8){a[0], a[1], a[2], a[3], b[0], b[1], b[2], b[3]}; }
__device__ __forceinline__ bf16x8 pack8(float a0, float a1, float a2, float a3, float a4, float a5, float a6, float a7) {
    u32x4 w; w.x = pk2(a0, a1); w.y = pk2(a2, a3); w.z = pk2(a4, a5); w.w = pk2(a6, a7);
    return __builtin_bit_cast(bf16x8, w);
}

__device__ __forceinline__ f32x16 zero16() { f32x16 z;
#pragma unroll
    for (int i = 0; i < 16; ++i) z[i] = 0.f;
    asm volatile("" : "+v"(z)); return z; }

struct Params { const float* in[25]; float* out; unsigned char* ws; int ph_lo, ph_hi; };

enum { EPI_SWIGLU = 0, EPI_RESID = 1, EPI_WINA = 2, EPI_WINB = 3, EPI_MERGE1 = 4, EPI_MERGE2 = 5, EPI_RESID_SPLIT = 6 };
constexpr size_t R_PART_OFF = 186;
template <int mode> struct Epi {
    static constexpr bool PERM = true, AFTER_DRAIN = false;
    int gate_i; float gscale; unsigned char* wsp; float* outp; const float* xp; const float* ctxp;
    __device__ __forceinline__ void operator()(const pg8::f32x4 (&acc)[2][2][4][2], const pg8::Unit& u, int wr, int wc, int fr, int fq) const {
        const int rowb = u.pm * 256 + wr * 64 + fr;
        const bool lat = (u.pm * 256) < LROWS;
        const int cin = wc * 32 + 8 * fq;
        unsigned char* const ws = wsp;
        if constexpr (mode == EPI_SWIGLU) {
            bf16_t* const o0 = (bf16_t*)(ws + R_U);
#pragma unroll
            for (int ai = 0; ai < 2; ++ai)
#pragma unroll
                for (int m = 0; m < 4; ++m) {
                    const int row = rowb + ai * 128 + m * 16;
                    const f32x4 a0 = acc[ai][0][m][0], a1 = acc[ai][0][m][1], b0 = acc[ai][1][m][0], b1 = acc[ai][1][m][1];
                    u32x4 w;
                    w.x = pk2(fast_silu(a0[0]) * b0[0], fast_silu(a0[1]) * b0[1]); w.y = pk2(fast_silu(a0[2]) * b0[2], fast_silu(a0[3]) * b0[3]);
                    w.z = pk2(fast_silu(a1[0]) * b1[0], fast_silu(a1[1]) * b1[1]); w.w = pk2(fast_silu(a1[2]) * b1[2], fast_silu(a1[3]) * b1[3]);
                    *(u32x4*)(o0 + (size_t)row * DFF + u.pn * 128 + cin) = w;
                }
        } else if constexpr (mode == EPI_RESID_SPLIT) {
            const float* const mod = (const float*)(ws + CTL_MOD);
            float* const part = (float*)(ws + WS_R + R_PART_OFF * MiB) + (size_t)(u.kb >> 2) * ((size_t)CROWS * DM);
#pragma unroll
            for (int ai = 0; ai < 2; ++ai)
#pragma unroll
                for (int m = 0; m < 4; ++m) {
                    const int row = rowb + ai * 128 + m * 16;
                    const float* gp = mod + (lat ? (row >> 13) : 4) * NMODC + 2 * DM;
#pragma unroll
                    for (int bj = 0; bj < 2; ++bj) {
                        const int col = u.pn * 256 + bj * 128 + cin;
                        const f32x4 g0 = *(const f32x4*)(gp + col), g1 = *(const f32x4*)(gp + col + 4);
                        if (lat) {
                            const f32x4 x0 = *(const f32x4*)(xp + (size_t)row * DM + col), x1 = *(const f32x4*)(xp + (size_t)row * DM + col + 4);
                            *(f32x4*)(outp + (size_t)row * DM + col) = x0 + 0.5f * g0 * acc[ai][bj][m][0];
                            *(f32x4*)(outp + (size_t)row * DM + col + 4) = x1 + 0.5f * g1 * acc[ai][bj][m][1];
                        } else {
                            float* po = part + (size_t)(row - LROWS) * DM + col;
                            *(f32x4*)po = 0.5f * g0 * acc[ai][bj][m][0];
                            *(f32x4*)(po + 4) = 0.5f * g1 * acc[ai][bj][m][1];
                        }
                    }
                }
        } else if constexpr (mode == EPI_RESID) {
            const bool first = (gate_i == 2);
            const float* const xin = first ? xp : outp; const float* const xinc = first ? ctxp : outp;
            float* const of32 = outp; float* const of32c = first ? (float*)(ws + R_XC1) : outp;
            const float* const mod = (const float*)(ws + CTL_MOD);
#pragma unroll
            for (int ai = 0; ai < 2; ++ai)
#pragma unroll
                for (int m = 0; m < 4; ++m) {
                    const int row = rowb + ai * 128 + m * 16;
                    const float* xi = lat ? xin + (size_t)row * DM : xinc + (size_t)(row - LROWS) * DM;
                    float* xo = lat ? of32 + (size_t)row * DM : of32c + (size_t)(row - LROWS) * DM;
                    const float* gp = mod + (lat ? (row >> 13) : 4) * NMODC + gate_i * DM;
#pragma unroll
                    for (int bj = 0; bj < 2; ++bj) {
                        const int col = u.pn * 256 + bj * 128 + cin;
                        const f32x4 g0 = *(const f32x4*)(gp + col), g1 = *(const f32x4*)(gp + col + 4);
                        const f32x4 x0 = *(const f32x4*)(xi + col), x1 = *(const f32x4*)(xi + col + 4);
                        *(f32x4*)(xo + col) = x0 + gscale * g0 * acc[ai][bj][m][0];
                        *(f32x4*)(xo + col + 4) = x1 + gscale * g1 * acc[ai][bj][m][1];
                    }
                }
        } else if constexpr (mode == EPI_WINA) {
            const int pn = u.pn;
            if (pn == 12) {
                float* const of32 = (float*)(ws + R_LR);
                if (wc == 0) {
#pragma unroll
                    for (int ai = 0; ai < 2; ++ai)
#pragma unroll
                        for (int m = 0; m < 4; ++m) {
                            const int row = rowb + ai * 128 + m * 16;
                            *(f32x4*)(of32 + (size_t)row * 32 + 8 * fq) = acc[ai][0][m][0];
                            *(f32x4*)(of32 + (size_t)row * 32 + 8 * fq + 4) = acc[ai][0][m][1];
                        }
                }
                return;
            }
            bf16_t* base; int ld, coff; float sc = 1.f; bool act = false;
            if (pn < 2) { if (!lat) return; base = (bf16_t*)(ws + R_GQ); ld = 512; coff = pn * 256; sc = QSCALE_GLA; }
            else if (pn < 4) { base = (bf16_t*)(ws + R_GK); ld = 512; coff = (pn - 2) * 256; }
            else if (pn < 8) { base = (bf16_t*)(ws + R_GV); ld = 1024; coff = (pn - 4) * 256; }
            else { if (!lat) return; base = (bf16_t*)(ws + WS_GG); ld = 1024; coff = (pn - 8) * 256; act = true; }
#pragma unroll
            for (int ai = 0; ai < 2; ++ai)
#pragma unroll
                for (int m = 0; m < 4; ++m) {
                    const int row = rowb + ai * 128 + m * 16;
#pragma unroll
                    for (int bj = 0; bj < 2; ++bj) {
                        f32x4 v0 = acc[ai][bj][m][0] * sc, v1 = acc[ai][bj][m][1] * sc;
                        if (act) {
#pragma unroll
                            for (int e = 0; e < 4; ++e) { v0[e] = fast_silu(v0[e]); v1[e] = fast_silu(v1[e]); }
                        }
                        u32x4 w; w.x = pk2(v0[0], v0[1]); w.y = pk2(v0[2], v0[3]); w.z = pk2(v1[0], v1[1]); w.w = pk2(v1[2], v1[3]);
                        *(u32x4*)(base + (size_t)row * ld + coff + bj * 128 + cin) = w;
                    }
                }
        } else if constexpr (mode == EPI_WINB) {
            const int pn = u.pn;
            bf16_t* base; int coff; float sc = 1.f; bool act = false, rope_on = false;
            const float* const rope = (const float*)(ws + CTL_ROPE);
            if (pn < 4) { if (!lat) return; base = (bf16_t*)(ws + R_DQ); coff = pn * 256; sc = C2ATT; rope_on = true; }
            else if (pn < 8) { base = (bf16_t*)(ws + R_DK); coff = (pn - 4) * 256; rope_on = lat; }
            else if (pn < 12) { base = (bf16_t*)(ws + R_DV); coff = (pn - 8) * 256; }
            else if (pn < 16) { if (!lat) return; base = (bf16_t*)(ws + R_GA); coff = (pn - 12) * 256; act = true; }
            else { if (!lat) return; base = (bf16_t*)(ws + R_GB); coff = (pn - 16) * 256; act = true; }
#pragma unroll
            for (int ai = 0; ai < 2; ++ai)
#pragma unroll
                for (int m = 0; m < 4; ++m) {
                    const int row = rowb + ai * 128 + m * 16;
#pragma unroll
                    for (int bj = 0; bj < 2; ++bj) {
                        f32x4 v0 = acc[ai][bj][m][0], v1 = acc[ai][bj][m][1];
                        if (rope_on) {
                            const int t = row & (SEQL - 1);
                            const int pos = (wc & 1) ? (t & 63) : (t >> 6);
                            const float* cp = rope + pos * 16 + 8 * (fq & 1);
                            const f32x4 c0 = *(const f32x4*)cp, c1 = *(const f32x4*)(cp + 4);
                            const f32x4 s0 = *(const f32x4*)(cp + 2048), s1 = *(const f32x4*)(cp + 2048 + 4);
                            const float sg = (fq < 2) ? -1.f : 1.f;
                            f32x4 p0, p1;
#pragma unroll
                            for (int e = 0; e < 4; ++e) {
                                auto r0 = __builtin_amdgcn_permlane32_swap(__float_as_uint(v0[e]), __float_as_uint(v0[e]), false, false);
                                auto r1 = __builtin_amdgcn_permlane32_swap(__float_as_uint(v1[e]), __float_as_uint(v1[e]), false, false);
                                p0[e] = __uint_as_float(fq >= 2 ? r0[0] : r0[1]); p1[e] = __uint_as_float(fq >= 2 ? r1[0] : r1[1]);
                            }
                            v0 = v0 * c0 + sg * p0 * s0; v1 = v1 * c1 + sg * p1 * s1;
                        }
                        v0 = v0 * sc; v1 = v1 * sc;
                        if (act) {
#pragma unroll
                            for (int e = 0; e < 4; ++e) { v0[e] = fast_sigmoid(v0[e]); v1[e] = fast_sigmoid(v1[e]); }
                        }
                        u32x4 w; w.x = pk2(v0[0], v0[1]); w.y = pk2(v0[2], v0[3]); w.z = pk2(v1[0], v1[1]); w.w = pk2(v1[2], v1[3]);
                        *(u32x4*)(base + (size_t)row * DM + coff + bj * 128 + cin) = w;
                    }
                }
        } else {
            bf16_t* const o0 = (bf16_t*)(ws + R_GA); const bf16_t* const o1 = (const bf16_t*)(ws + R_GB);
#pragma unroll
            for (int ai = 0; ai < 2; ++ai)
#pragma unroll
                for (int m = 0; m < 4; ++m) {
                    const int row = rowb + ai * 128 + m * 16;
#pragma unroll
                    for (int bj = 0; bj < 2; ++bj) {
                        const size_t off = (size_t)row * DM + u.pn * 256 + bj * 128 + cin;
                        const u32x4 ga = *(const u32x4*)(o0 + off);
                        const f32x4 v0 = acc[ai][bj][m][0], v1 = acc[ai][bj][m][1];
                        float r[8];
                        if constexpr (mode == EPI_MERGE1) {
                            r[0] = bflo(ga.x) * v0[0]; r[1] = bfhi(ga.x) * v0[1]; r[2] = bflo(ga.y) * v0[2]; r[3] = bfhi(ga.y) * v0[3];
                            r[4] = bflo(ga.z) * v1[0]; r[5] = bfhi(ga.z) * v1[1]; r[6] = bflo(ga.w) * v1[2]; r[7] = bfhi(ga.w) * v1[3];
                        } else {
                            const u32x4 gb = *(const u32x4*)(o1 + off);
                            r[0] = bflo(ga.x) + bflo(gb.x) * v0[0]; r[1] = bfhi(ga.x) + bfhi(gb.x) * v0[1]; r[2] = bflo(ga.y) + bflo(gb.y) * v0[2]; r[3] = bfhi(ga.y) + bfhi(gb.y) * v0[3];
                            r[4] = bflo(ga.z) + bflo(gb.z) * v1[0]; r[5] = bfhi(ga.z) + bfhi(gb.z) * v1[1]; r[6] = bflo(ga.w) + bflo(gb.w) * v1[2]; r[7] = bfhi(ga.w) + bfhi(gb.w) * v1[3];
                        }
                        u32x4 w; w.x = pk2(r[0], r[1]); w.y = pk2(r[2], r[3]); w.z = pk2(r[4], r[5]); w.w = pk2(r[6], r[7]);
                        *(u32x4*)(o0 + off) = w;
                    }
                }
        }
    }
};

__device__ __forceinline__ void transpose_item(const float* W, int ldw, int src_n0, bf16_t* WT, int K, int dst_r0, int k0, LAS float* scr, int lane) {
    if (src_n0 >= 0) {
#pragma unroll 8
        for (int i = 0; i < 32; ++i) { const int kk = 2 * i + (lane >> 5); scr[kk * 33 + (lane & 31)] = W[(size_t)(k0 + kk) * ldw + src_n0 + (lane & 31)]; }
    } else {
#pragma unroll 8
        for (int i = 0; i < 32; ++i) { const int kk = 2 * i + (lane >> 5); scr[kk * 33 + (lane & 31)] = 0.f; }
    }
    asm volatile("s_waitcnt lgkmcnt(0)" ::: "memory");
    const int c = lane & 7;
#pragma unroll
    for (int j = 0; j < 4; ++j) {
        const int n = (lane >> 3) + 8 * j; const LAS float* s = scr + (8 * c) * 33 + n;
        u32x4 o; o.x = pk2(s[0 * 33], s[1 * 33]); o.y = pk2(s[2 * 33], s[3 * 33]); o.z = pk2(s[4 * 33], s[5 * 33]); o.w = pk2(s[6 * 33], s[7 * 33]);
        *(u32x4*)(WT + (size_t)(dst_r0 + n) * K + k0 + 8 * c) = o;
    }
    asm volatile("s_waitcnt lgkmcnt(0)" ::: "memory");
}

__device__ __forceinline__ void phase_prep(const Params& p, LAS unsigned char* lds) {
    const int tid = threadIdx.x, lane = tid & 63, wave = tid >> 6;
    unsigned char* ws = p.ws;
    {
        LAS float* sc = (LAS float*)lds;
        LAS float* red = (LAS float*)(lds + 20480);
        for (int i = tid; i < 5 * DM; i += 512) { const int v = i >> 10, k = i & 1023; const float cv = (v < 4) ? p.in[1][v * DM + k] : p.in[3][k]; sc[i] = fast_silu(cv); }
        __syncthreads();
        float* MOD = (float*)(ws + CTL_MOD);
        for (int it = blockIdx.x; it < 72; it += gridDim.x) {
            const int col = tid & 127, kq = tid >> 7, j = it * 128 + col, kb = kq * 256;
            float a0 = 0.f, a1 = 0.f, a2 = 0.f, a3 = 0.f, a4 = 0.f;
#pragma unroll 32
            for (int k = 0; k < 256; ++k) {
                const float w = p.in[4][(size_t)(kb + k) * NMODC + j];
                a0 += sc[kb + k] * w; a1 += sc[DM + kb + k] * w; a2 += sc[2 * DM + kb + k] * w; a3 += sc[3 * DM + kb + k] * w; a4 += sc[4 * DM + kb + k] * w;
            }
            red[(kq * 5 + 0) * 128 + col] = a0; red[(kq * 5 + 1) * 128 + col] = a1; red[(kq * 5 + 2) * 128 + col] = a2; red[(kq * 5 + 3) * 128 + col] = a3; red[(kq * 5 + 4) * 128 + col] = a4;
            __syncthreads();
            for (int o = tid; o < 640; o += 512) {
                const int v = o >> 7, c = o & 127;
                MOD[v * NMODC + it * 128 + c] = p.in[5][it * 128 + c] + ((red[(0 * 5 + v) * 128 + c] + red[(1 * 5 + v) * 128 + c]) + (red[(2 * 5 + v) * 128 + c] + red[(3 * 5 + v) * 128 + c]));
            }
            __syncthreads();
        }
        __syncthreads();
    }
    if (blockIdx.x == 0) {
        float* rope = (float*)(ws + CTL_ROPE);
        for (int i = tid; i < 2048; i += 512) {
            const int pos = i >> 4, q = i & 15;
            const float inv = powf(10000.f, -(float)q / 16.f);
            const float ang = (float)pos * inv;
            rope[i] = cosf(ang); rope[2048 + i] = sinf(ang);
        }
    }
    if (blockIdx.x == (gridDim.x > 1 ? 1 : 0) && tid == 0) {
        const float* dl = p.in[15];
        float s1 = 0.f, s2 = 0.f;
        for (int i = 0; i < 64; ++i) { s1 += dl[i] * dl[64 + i]; s2 += dl[128 + i] * dl[192 + i]; }
        *(float*)(ws + CTL_LAM) = expf(s1) - expf(s2) + LAM_INIT;
    }
}

__device__ __forceinline__ void phase_wcopy(const Params& p, LAS unsigned char* lds) {
    const int tid = threadIdx.x, lane = tid & 63, wave = tid >> 6;
    unsigned char* ws = p.ws;
    LAS float* scr = (LAS float*)(lds + 32768 + wave * 8448);
    const int gw = blockIdx.x * 8 + wave, NGW = gridDim.x * 8;
    constexpr int I_13 = 176 * 16, I_2 = 32 * 44, I_WA = 104 * 16, I_WB = 160 * 16, I_SQ = 32 * 16;
    constexpr int NITEMS = 2 * I_13 + 2 * I_2 + I_WA + I_WB + 3 * I_SQ;
    for (int it = gw; it < NITEMS; it += NGW) {
        int r = it;
        if (r < 2 * I_13) {
            const int second = r >= I_13; if (second) r -= I_13;
            const int rb = r / 16, kb = r % 16, pn = rb >> 3, jb = rb & 7;
            const float* src = (jb < 4) ? p.in[second ? 21 : 7] : p.in[second ? 22 : 8];
            transpose_item(src, DFF, pn * 128 + (jb & 3) * 32, (bf16_t*)(ws + (second ? W_W13B : W_W13A)), DM, rb * 32, kb * 64, scr, lane);
            continue;
        }
        r -= 2 * I_13;
        if (r < 2 * I_2) {
            const int second = r >= I_2; if (second) r -= I_2;
            const int rb = r / 44, kb = r % 44;
            transpose_item(p.in[second ? 23 : 9], DM, rb * 32, (bf16_t*)(ws + (second ? W_W2B : W_W2A)), DFF, rb * 32, kb * 64, scr, lane);
            continue;
        }
        r -= 2 * I_2;
        if (r < I_WA) {
            const int rb = r / 16, kb = r % 16;
            transpose_item(p.in[11], 8224, rb < 97 ? rb * 32 : -1, (bf16_t*)(ws + W_WINA), DM, rb * 32, kb * 64, scr, lane);
            continue;
        }
        r -= I_WA;
        if (r < I_WB) {
            const int rb = r / 16, kb = r % 16;
            transpose_item(p.in[11], 8224, 3104 + rb * 32, (bf16_t*)(ws + W_WINB), DM, rb * 32, kb * 64, scr, lane);
            continue;
        }
        r -= I_WB;
        {
            const int which = r / I_SQ; r -= which * I_SQ;
            const int rb = r / 16, kb = r % 16;
            transpose_item(p.in[17 + which], DM, rb * 32, (bf16_t*)(ws + (which == 0 ? W_WBG : which == 1 ? W_WBD : W_WOUT)), DM, rb * 32, kb * 64, scr, lane);
        }
    }
}

__device__ __forceinline__ void phase_modnorm(const float* lat, const float* ctxp, int nrows, const float* normw, const float* mod, int shift_i, int scale_i, bf16_t* H, const float* part = nullptr) {
    const int lane = threadIdx.x & 63, wave = threadIdx.x >> 6;
    const int gw = blockIdx.x * 8 + wave, NGW = gridDim.x * 8;
    for (int row = gw; row < nrows; row += NGW) {
        const bool isl = row < LROWS;
        const float* src = isl ? lat + (size_t)row * DM : ctxp + (size_t)(row - LROWS) * DM;
        const float* mp = mod + (isl ? (row >> 13) : 4) * NMODC;
        f32x4 v[4]; float ss = 0.f;
#pragma unroll
        for (int j = 0; j < 4; ++j) {
            v[j] = *(const f32x4*)(src + 256 * j + 4 * lane);
            if (part != nullptr && !isl) {
#pragma unroll
                for (int sk = 0; sk < 11; ++sk) v[j] += *(const f32x4*)(part + (size_t)sk * ((size_t)CROWS * DM) + (size_t)(row - LROWS) * DM + 256 * j + 4 * lane);
            }
            ss += (v[j].x * v[j].x + v[j].y * v[j].y) + (v[j].z * v[j].z + v[j].w * v[j].w); }
        const float r = rsqrtf(wave_sum(ss) * (1.f / DM) + EPSN);
#pragma unroll
        for (int j = 0; j < 4; ++j) {
            const int c = 256 * j + 4 * lane;
            const f32x4 g = *(const f32x4*)(normw + c), sc = *(const f32x4*)(mp + scale_i * DM + c), sh = *(const f32x4*)(mp + shift_i * DM + c);
            const f32x4 y = (v[j] * r * g) * (1.f + sc) + sh;
            u32x2 w; w.x = pk2(y.x, y.y); w.y = pk2(y.z, y.w);
            *(u32x2*)(H + (size_t)row * DM + c) = w;
        }
    }
}
__device__ __forceinline__ void phase_finalnorm(float* xo, const float* normw) {
    const int lane = threadIdx.x & 63, wave = threadIdx.x >> 6;
    const int gw = blockIdx.x * 8 + wave, NGW = gridDim.x * 8;
    for (int row = gw; row < LROWS; row += NGW) {
        float* src = xo + (size_t)row * DM;
        f32x4 v[4]; float ss = 0.f;
#pragma unroll
        for (int j = 0; j < 4; ++j) { v[j] = *(const f32x4*)(src + 256 * j + 4 * lane); ss += (v[j].x * v[j].x + v[j].y * v[j].y) + (v[j].z * v[j].z + v[j].w * v[j].w); }
        const float r = rsqrtf(wave_sum(ss) * (1.f / DM) + EPSN);
#pragma unroll
        for (int j = 0; j < 4; ++j) { const int c = 256 * j + 4 * lane; const f32x4 g = *(const f32x4*)(normw + c); *(f32x4*)(src + c) = v[j] * r * g; }
    }
}

__device__ __forceinline__ int gla_row(int b, int cid, int t) { return cid < 4 ? LROWS + b * NCTX + cid * 64 + t : b * SEQL + (cid - 4) * 64 + t; }
__device__ __forceinline__ bf16x8 tr_frag(const LAS unsigned char* tile, int stride, int k0, int c0, int lane) {
    const int h = lane >> 5, q = (lane & 15) >> 2, pp = lane & 3, g1 = (lane >> 4) & 1;
    const LAS unsigned char* a = tile + (k0 + 8 * h + q) * stride + (c0 + 16 * g1 + 4 * pp) * 2;
    return cat8(vtr(a), vtr(a + 4 * stride));
}
__device__ __forceinline__ bf16x8 tr_frag_perm(const LAS unsigned char* tile, int stride, int k0, int c0, int lane) {
    const int h = lane >> 5, q = (lane & 15) >> 2, pp = lane & 3, g1 = (lane >> 4) & 1;
    const LAS unsigned char* a = tile + (k0 + 4 * h + q) * stride + (c0 + 16 * g1 + 4 * pp) * 2;
    return cat8(vtr(a), vtr(a + 8 * stride));
}
__device__ __forceinline__ bf16x8 row_frag(const LAS unsigned char* tile, int stride, int r0, int k0, int lane) {
    return *(const LAS bf16x8*)(tile + (r0 + (lane & 31)) * stride + (k0 + 8 * (lane >> 5)) * 2);
}

constexpr int VT_STRIDE = 576, KH_STRIDE = 320, QK_STRIDE = 272, AM_STRIDE = 144, OB_STRIDE = 1040;

__device__ __forceinline__ void gla_stage(const unsigned char* ws, int b, int h, int cid, LAS float* lrs, LAS unsigned char* vt, LAS unsigned char* rawk, LAS unsigned char* rawq) {
    const int tid = threadIdx.x;
    const float* LR = (const float*)(ws + R_LR); const bf16_t* GV = (const bf16_t*)(ws + R_GV);
    const bf16_t* GK = (const bf16_t*)(ws + R_GK); const bf16_t* GQ = (const bf16_t*)(ws + R_GQ);
    { const int t = tid >> 3, c = (tid & 7) * 4; *(LAS f32x4*)(lrs + t * 32 + c) = *(const f32x4*)(LR + (size_t)gla_row(b, cid, t) * 32 + c); }
#pragma unroll
    for (int i = 0; i < 4; ++i) {
        const int idx = tid + 512 * i, t = idx >> 5, ch = idx & 31;
        *(LAS u32x4*)(vt + t * VT_STRIDE + ch * 16) = *(const u32x4*)(GV + (size_t)gla_row(b, cid, t) * DM + h * 256 + ch * 8);
    }
#pragma unroll
    for (int i = 0; i < 2; ++i) {
        const int idx = tid + 512 * i, t = idx >> 4, ch = idx & 15;
        const size_t g = (size_t)gla_row(b, cid, t) * 512 + h * 128 + ch * 8;
        *(LAS u32x4*)(rawk + t * 256 + ch * 16) = *(const u32x4*)(GK + g);
        if (rawq) *(LAS u32x4*)(rawq + t * 256 + ch * 16) = *(const u32x4*)(GQ + g);
    }
}

__device__ __forceinline__ void gla_gates(const LAS float* lrs, const float* W2, const float* bias, int h, int dir, int dblk, int lane, float (&L)[2][16], float (&P)[2][16], float& total) {
    const int r32 = lane & 31, hh = lane >> 5, d = 32 * dblk + r32;
    float wv[8];
#pragma unroll
    for (int j = 0; j < 8; ++j) wv[j] = W2[(size_t)(dir * 16 + 8 * hh + j) * 512 + h * 128 + d];
    u32x4 wh, wl;
    wh.x = pk2(wv[0], wv[1]); wh.y = pk2(wv[2], wv[3]); wh.z = pk2(wv[4], wv[5]); wh.w = pk2(wv[6], wv[7]);
    wl.x = pk2(wv[0] - bflo(wh.x), wv[1] - bfhi(wh.x)); wl.y = pk2(wv[2] - bflo(wh.y), wv[3] - bfhi(wh.y));
    wl.z = pk2(wv[4] - bflo(wh.z), wv[5] - bfhi(wh.z)); wl.w = pk2(wv[6] - bflo(wh.w), wv[7] - bfhi(wh.w));
    const bf16x8 whi = __builtin_bit_cast(bf16x8, wh), wlo = __builtin_bit_cast(bf16x8, wl);
    const float bs = bias[dir * 512 + h * 128 + d];
#pragma unroll
    for (int th = 0; th < 2; ++th) {
        const LAS float* ap = lrs + (32 * th + r32) * 32 + dir * 16 + 8 * hh;
        const f32x4 a0 = *(const LAS f32x4*)ap, a1 = *(const LAS f32x4*)(ap + 4);
        u32x4 ah, al;
        ah.x = pk2(a0.x, a0.y); ah.y = pk2(a0.z, a0.w); ah.z = pk2(a1.x, a1.y); ah.w = pk2(a1.z, a1.w);
        al.x = pk2(a0.x - bflo(ah.x), a0.y - bfhi(ah.x)); al.y = pk2(a0.z - bflo(ah.y), a0.w - bfhi(ah.y));
        al.z = pk2(a1.x - bflo(ah.z), a1.y - bfhi(ah.z)); al.w = pk2(a1.z - bflo(ah.w), a1.w - bfhi(ah.w));
        const bf16x8 ahi = __builtin_bit_cast(bf16x8, ah), alo = __builtin_bit_cast(bf16x8, al);
        f32x16 z;
#pragma unroll
        for (int i = 0; i < 16; ++i) z[i] = bs;
        z = __builtin_amdgcn_mfma_f32_32x32x16_bf16(ahi, whi, z, 0, 0, 0);
        z = __builtin_amdgcn_mfma_f32_32x32x16_bf16(alo, whi, z, 0, 0, 0);
        z = __builtin_amdgcn_mfma_f32_32x32x16_bf16(ahi, wlo, z, 0, 0, 0);
#pragma unroll
        for (int i = 0; i < 16; ++i) L[th][i] = logsigmoid_f(z[i]) * (1.f / 16.f);
    }
    float base = 0.f;
#pragma unroll
    for (int th = 0; th < 2; ++th)
#pragma unroll
        for (int g = 0; g < 4; ++g) {
            const float p0 = L[th][4 * g], p1 = p0 + L[th][4 * g + 1], p2 = p1 + L[th][4 * g + 2], p3 = p2 + L[th][4 * g + 3];
            auto rr = __builtin_amdgcn_permlane32_swap(__float_as_uint(p3), __float_as_uint(p3), false, false);
            const float gp = __uint_as_float(hh ? rr[0] : rr[1]);
            const float off = hh ? base + gp : base;
            P[th][4 * g] = off + p0; P[th][4 * g + 1] = off + p1; P[th][4 * g + 2] = off + p2; P[th][4 * g + 3] = off + p3;
            base += p3 + gp;
        }
    total = base;
}

__device__ __forceinline__ void phase_gla_a(const Params& p, LAS unsigned char* lds, int half) {
    const int tid = threadIdx.x, lane = tid & 63, wave = tid >> 6;
    unsigned char* ws = p.ws;
    LAS float* lrs = (LAS float*)lds;
    LAS unsigned char* vt = lds + 8192;
    LAS unsigned char* kh = lds + 8192 + 36864;
    LAS unsigned char* rawk = lds + 8192 + 36864 + 40960;
    const bf16_t* GK = (const bf16_t*)(ws + R_GK);
    float* DEC = (float*)(ws + R_DEC);
    bf16_t* Sb = (bf16_t*)(ws + R_S);
    for (int it = blockIdx.x; it < 2 * 4 * NCH; it += gridDim.x) {
        const int bl = it / (4 * NCH), h = (it / NCH) & 3, cid = it % NCH, b = half * 2 + bl;
        gla_stage(ws, b, h, cid, lrs, vt, rawk, nullptr);
        __syncthreads();
        {
            const int dir = wave >> 2, dblk = wave & 3, d = 32 * dblk + (lane & 31), hh = lane >> 5;
            float L[2][16], P[2][16], total;
            gla_gates(lrs, p.in[12], p.in[13], h, dir, dblk, lane, L, P, total);
            LAS unsigned char* khd = kh + dir * (64 * KH_STRIDE);
#pragma unroll
            for (int th = 0; th < 2; ++th)
#pragma unroll
                for (int i = 0; i < 16; ++i) {
                    const int t = 32 * th + 8 * (i >> 2) + 4 * hh + (i & 3);
                    const float e = dir == 0 ? total - P[th][i] : P[th][i] - L[th][i];
                    const float kv = bf2f(*(const LAS unsigned short*)(rawk + t * 256 + d * 2));
                    *(LAS unsigned short*)(khd + t * KH_STRIDE + d * 2) = f2bf(kv * __expf(e));
                }
            if (hh == 0) DEC[((size_t)it * 2 + dir) * 128 + d] = __expf(total);
        }
        __syncthreads();
#pragma unroll 1
        for (int dir = 0; dir < 2; ++dir) {
            const LAS unsigned char* khd = kh + dir * (64 * KH_STRIDE);
            f32x16 acc[4];
#pragma unroll
            for (int mb = 0; mb < 4; ++mb) acc[mb] = zero16();
#pragma unroll
            for (int ks = 0; ks < 4; ++ks) {
                const bf16x8 bfr = tr_frag(vt, VT_STRIDE, 16 * ks, 32 * wave, lane);
#pragma unroll
                for (int mb = 0; mb < 4; ++mb) {
                    const bf16x8 afr = tr_frag(khd, KH_STRIDE, 16 * ks, 32 * mb, lane);
                    acc[mb] = __builtin_amdgcn_mfma_f32_32x32x16_bf16(afr, bfr, acc[mb], 0, 0, 0);
                }
            }
            bf16_t* So = Sb + ((size_t)(((bl * 2 + dir) * 4 + h) * NCH + cid)) * 32768 + (size_t)wave * 4096 + (lane & 31) * 8 + 4 * (lane >> 5);
#pragma unroll
            for (int mb = 0; mb < 4; ++mb)
#pragma unroll
                for (int g = 0; g < 4; ++g) {
                    u32x2 w; w.x = pk2(acc[mb][4 * g], acc[mb][4 * g + 1]); w.y = pk2(acc[mb][4 * g + 2], acc[mb][4 * g + 3]);
                    *(u32x2*)(So + ((2 * mb + (g >> 1)) * 2 + (g & 1)) * 256) = w;
                }
        }
        __syncthreads();
    }
}

__device__ __forceinline__ void phase_gla_scan(const Params& p) {
    const int tid = threadIdx.x;
    unsigned char* ws = p.ws;
    const float* DEC = (const float*)(ws + R_DEC);
    bf16_t* Sb = (bf16_t*)(ws + R_S);
    for (int it = blockIdx.x; it < 256; it += gridDim.x) {
        const int seq = it >> 4, part = it & 15;
        const int bl = seq >> 3, dir = (seq >> 2) & 1, h = seq & 3;
        const int eo = part * 2048 + tid * 4, d = 16 * ((eo >> 9) & 7) + 8 * ((eo >> 8) & 1) + (eo & 7);
        float S0 = 0.f, S1 = 0.f, S2 = 0.f, S3 = 0.f;
        bf16_t* sbase = Sb + (size_t)(((bl * 2 + dir) * 4 + h) * NCH) * 32768 + eo;
        const float* dbase = DEC + ((size_t)((bl * 4 + h) * NCH) * 2 + dir) * 128 + d;
        u32x2 dvA[6]; f32x4 dcA[6];
#pragma unroll
        for (int j = 0; j < 6; ++j) {
            const int cid = dir == 0 ? j : (j < 4 ? 3 - j : 135 - j);
            dvA[j] = *(const u32x2*)(sbase + (size_t)cid * 32768); dcA[j] = *(const f32x4*)(dbase + (size_t)cid * 256);
        }
#pragma unroll 1
        for (int st = 0; st < NCH; st += 6) {
            u32x2 dvB[6]; f32x4 dcB[6];
            const int sn = st + 6 < NCH ? st + 6 : st;
#pragma unroll
            for (int j = 0; j < 6; ++j) {
                const int s2 = sn + j, cid = dir == 0 ? s2 : (s2 < 4 ? 3 - s2 : 135 - s2);
                dvB[j] = *(const u32x2*)(sbase + (size_t)cid * 32768); dcB[j] = *(const f32x4*)(dbase + (size_t)cid * 256);
            }
#pragma unroll
            for (int j = 0; j < 6; ++j) {
                const int s2 = st + j, cid = dir == 0 ? s2 : (s2 < 4 ? 3 - s2 : 135 - s2);
                u32x2 w; w.x = pk2(S0, S1); w.y = pk2(S2, S3);
                *(u32x2*)(sbase + (size_t)cid * 32768) = w;
                S0 = dcA[j].x * S0 + bflo(dvA[j].x); S1 = dcA[j].y * S1 + bfhi(dvA[j].x); S2 = dcA[j].z * S2 + bflo(dvA[j].y); S3 = dcA[j].w * S3 + bfhi(dvA[j].y);
            }
#pragma unroll
            for (int j = 0; j < 6; ++j) { dvA[j] = dvB[j]; dcA[j] = dcB[j]; }
        }
    }
}

__device__ __forceinline__ void phase_gla_c(const Params& p, LAS unsigned char* lds, int half, bool to_scratch = false) {
    const int tid = threadIdx.x, lane = tid & 63, wave = tid >> 6;
    unsigned char* ws = p.ws;
    LAS unsigned char* qk = lds;
    LAS unsigned char* vt = lds + 69632;
    LAS float* lrs = (LAS float*)(lds + 69632 + 36864);
    LAS unsigned char* rawk = lds + 69632 + 36864 + 8192;
    LAS unsigned char* rawq = lds + 69632 + 36864 + 8192 + 16384;
    LAS unsigned char* am = rawq;
    static_assert(69632 + 36864 + 8192 + 16384 + 16384 <= LDS_BYTES, "GLA (c) LDS");
    const bf16_t* GQ = (const bf16_t*)(ws + R_GQ); const bf16_t* GK = (const bf16_t*)(ws + R_GK);
    const bf16_t* Sb = (const bf16_t*)(ws + R_S);
    bf16_t* GG = (bf16_t*)(ws + WS_GG);
    for (int it = blockIdx.x; it < 2 * 4 * 128; it += gridDim.x) {
        const int bl = it >> 9, h = (it >> 7) & 3, lc = it & 127, cid = lc + 4, b = half * 2 + bl;
        bf16x8 sfr[2][8];
#pragma unroll
        for (int dir = 0; dir < 2; ++dir) {
            const bf16_t* Sp = Sb + ((size_t)(((bl * 2 + dir) * 4 + h) * NCH + cid)) * 32768 + (size_t)wave * 4096 + (lane >> 5) * 256 + (lane & 31) * 8;
#pragma unroll
            for (int ks = 0; ks < 8; ++ks) sfr[dir][ks] = *(const bf16x8*)(Sp + 512 * ks);
        }
        gla_stage(ws, b, h, cid, lrs, vt, rawk, rawq);
        __syncthreads();
        {
            const int dir = wave >> 2, dblk = wave & 3, d = 32 * dblk + (lane & 31), hh = lane >> 5;
            float L[2][16], P[2][16], total;
            gla_gates(lrs, p.in[12], p.in[13], h, dir, dblk, lane, L, P, total);
            LAS unsigned char* qd = qk + (dir * 2) * (64 * QK_STRIDE);
            LAS unsigned char* kd = qk + (dir * 2 + 1) * (64 * QK_STRIDE);
#pragma unroll
            for (int th = 0; th < 2; ++th)
#pragma unroll
                for (int i = 0; i < 16; ++i) {
                    const int t = 32 * th + 8 * (i >> 2) + 4 * hh + (i & 3);
                    const float e = dir == 0 ? P[th][i] : total - P[th][i] + L[th][i];
                    const float qv = bf2f(*(const LAS unsigned short*)(rawq + t * 256 + d * 2));
                    const float kv = bf2f(*(const LAS unsigned short*)(rawk + t * 256 + d * 2));
                    *(LAS unsigned short*)(qd + t * QK_STRIDE + d * 2) = f2bf(qv * __expf(e));
                    *(LAS unsigned short*)(kd + t * QK_STRIDE + d * 2) = f2bf(kv * __expf(-e));
                }
        }
        __syncthreads();
        if (wave < 4) {
            const int th = wave >> 1, sh = wave & 1;
            f32x16 cf = zero16(), cb = zero16();
#pragma unroll
            for (int ks = 0; ks < 8; ++ks) {
                const bf16x8 aqf = row_frag(qk, QK_STRIDE, 32 * th, 16 * ks, lane);
                const bf16x8 bkf = row_frag(qk + 1 * (64 * QK_STRIDE), QK_STRIDE, 32 * sh, 16 * ks, lane);
                cf = __builtin_amdgcn_mfma_f32_32x32x16_bf16(aqf, bkf, cf, 0, 0, 0);
                const bf16x8 aqb = row_frag(qk + 2 * (64 * QK_STRIDE), QK_STRIDE, 32 * th, 16 * ks, lane);
                const bf16x8 bkb = row_frag(qk + 3 * (64 * QK_STRIDE), QK_STRIDE, 32 * sh, 16 * ks, lane);
                cb = __builtin_amdgcn_mfma_f32_32x32x16_bf16(aqb, bkb, cb, 0, 0, 0);
            }
            const int sg = 32 * sh + (lane & 31);
#pragma unroll
            for (int i = 0; i < 16; ++i) {
                const int tg = 32 * th + 8 * (i >> 2) + 4 * (lane >> 5) + (i & 3);
                const float v = (sg <= tg ? cf[i] : 0.f) + (sg >= tg ? cb[i] : 0.f);
                const unsigned hv = f2bf(v), ov = __shfl_xor(hv, 1);
                if (!(lane & 1)) *(LAS unsigned*)(am + tg * AM_STRIDE + sg * 2) = hv | (ov << 16);
            }
        }
        f32x16 oacc[2]; oacc[0] = zero16(); oacc[1] = zero16();
#pragma unroll
        for (int dir = 0; dir < 2; ++dir)
#pragma unroll
            for (int ks = 0; ks < 8; ++ks)
#pragma unroll
                for (int th = 0; th < 2; ++th) {
                    const bf16x8 a = row_frag(qk + (dir * 2) * (64 * QK_STRIDE), QK_STRIDE, 32 * th, 16 * ks, lane);
                    oacc[th] = __builtin_amdgcn_mfma_f32_32x32x16_bf16(a, sfr[dir][ks], oacc[th], 0, 0, 0);
                }
        __syncthreads();
#pragma unroll
        for (int ks = 0; ks < 4; ++ks) {
            const bf16x8 bfr = tr_frag(vt, VT_STRIDE, 16 * ks, 32 * wave, lane);
#pragma unroll
            for (int th = 0; th < 2; ++th) {
                const bf16x8 a = row_frag(am, AM_STRIDE, 32 * th, 16 * ks, lane);
                oacc[th] = __builtin_amdgcn_mfma_f32_32x32x16_bf16(a, bfr, oacc[th], 0, 0, 0);
            }
        }
        __syncthreads();
#pragma unroll
        for (int th = 0; th < 2; ++th)
#pragma unroll
            for (int i = 0; i < 16; ++i) {
                const int tg = 32 * th + 8 * (i >> 2) + 4 * (lane >> 5) + (i & 3);
                *(LAS float*)(qk + tg * OB_STRIDE + (32 * wave + (lane & 31)) * 4) = oacc[th][i];
            }
        __syncthreads();
        {
            u32x2 gt[8]; f32x4 ov[8]; float ssv[8];
            const f32x4 g = *(const f32x4*)(p.in[14] + h * 256 + 4 * lane);
#pragma unroll
            for (int rr = 0; rr < 8; ++rr) {
                const int t = wave * 8 + rr;
                gt[rr] = *(const u32x2*)(GG + (size_t)gla_row(b, cid, t) * DM + h * 256 + 4 * lane);
                ov[rr] = *(const LAS f32x4*)(qk + t * OB_STRIDE + lane * 16);
                ssv[rr] = (ov[rr].x * ov[rr].x + ov[rr].y * ov[rr].y) + (ov[rr].z * ov[rr].z + ov[rr].w * ov[rr].w);
            }
#pragma unroll
            for (int o = 1; o < 64; o <<= 1)
#pragma unroll
                for (int rr = 0; rr < 8; ++rr) ssv[rr] += __shfl_xor(ssv[rr], o);
#pragma unroll
            for (int rr = 0; rr < 8; ++rr) {
                const int t = wave * 8 + rr;
                const float r = rsqrtf(ssv[rr] * (1.f / 256.f) + EPSN);
                u32x2 w; w.x = pk2(ov[rr].x * r * g.x * bflo(gt[rr].x), ov[rr].y * r * g.y * bfhi(gt[rr].x)); w.y = pk2(ov[rr].z * r * g.z * bflo(gt[rr].y), ov[rr].w * r * g.w * bfhi(gt[rr].y));
                *(u32x2*)((to_scratch ? (bf16_t*)(ws + R_GA) : GG) + (size_t)gla_row(b, cid, t) * DM + h * 256 + 4 * lane) = w;
            }
        }
        __syncthreads();
    }
}

constexpr int AQ_STRIDE = 272, ATILE = 64 * 256;
__device__ __forceinline__ int att_krow(int b, int tile, int r) { return tile < 4 ? LROWS + b * NCTX + tile * 64 + r : b * SEQL + (tile - 4) * 64 + r; }
__device__ __forceinline__ void att_dma_tile(const bf16_t* DK, const bf16_t* DV, int b, int hd, int tile, LAS unsigned char* kdst, LAS unsigned char* vdst, int wave_u, int lane) {
#pragma unroll
    for (int i = 0; i < 2; ++i) {
        const int j = wave_u + 8 * i;
        const int row = 4 * j + (lane >> 4), pc = lane & 15;
        const size_t g = (size_t)att_krow(b, tile, row) * DM + hd * 128;
        __builtin_amdgcn_global_load_lds((const unsigned*)(DK + g + ((pc ^ (row & 15)) << 3)), (LAS unsigned*)(kdst + j * 1024), 16, 0, 0);
        __builtin_amdgcn_global_load_lds((const unsigned*)(DV + g + ((pc ^ ((row & 3) << 2)) << 3)), (LAS unsigned*)(vdst + j * 1024), 16, 0, 0);
    }
}

template <bool SAFE>
__device__ __forceinline__ bool att_unit(const Params& p, LAS unsigned char* lds, int b, int hd, int qb) {
    const int tid = threadIdx.x, lane = tid & 63, wave = __builtin_amdgcn_readfirstlane(tid >> 6), r32 = lane & 31, hi = lane >> 5;
    unsigned char* ws = p.ws;
    const bf16_t* DQ = (const bf16_t*)(ws + R_DQ); const bf16_t* DK = (const bf16_t*)(ws + R_DK); const bf16_t* DV = (const bf16_t*)(ws + R_DV);
    const float lam = *(const float*)(ws + CTL_LAM);
    LAS unsigned char* kbuf = lds;
    LAS unsigned char* vbuf = lds + 2 * ATILE;
    LAS unsigned char* qbuf = lds + 4 * ATILE;
    static_assert(4 * ATILE + 8 * 32 * AQ_STRIDE + 2048 <= LDS_BARST, "attention LDS");
        const int qrow = b * SEQL + qb * 256 + wave * 32 + r32;
        {
            int l0 = lane; asm volatile("" : "+v"(l0));
            LAS unsigned char* qw = qbuf + wave * (32 * AQ_STRIDE);
#pragma unroll
            for (int i = 0; i < 8; ++i) {
                const int idx = l0 + 64 * i, row = idx >> 4, ch = idx & 15;
                *(LAS u32x4*)(qw + row * AQ_STRIDE + ch * 16) = *(const u32x4*)(DQ + (size_t)(b * SEQL + qb * 256 + wave * 32 + row) * DM + hd * 128 + ch * 8);
            }
            asm volatile("" ::: "memory");
            att_dma_tile(DK, DV, b, hd, 0, kbuf, vbuf, wave, l0);
            asm volatile("" ::: "memory");
        }
        f32x16 O[2][4];
#pragma unroll
        for (int c = 0; c < 2; ++c)
#pragma unroll
            for (int j = 0; j < 4; ++j) O[c][j] = zero16();
        float mrun[2] = {-1e30f, -1e30f}, lrun[2] = {0.f, 0.f};
        asm volatile("s_waitcnt vmcnt(0)" ::: "memory");
        __syncthreads();
        if constexpr (!SAFE) { if (tid == 0) *(volatile LAS unsigned*)(lds + LDS_BARST + 16) = 0u; }
#pragma unroll 1
        for (int tile = 0; tile < NCH; ++tile) {
            int tl = tid; asm volatile("" : "+v"(tl));
            const int ln = tl & 63, lr = ln & 31, lh = ln >> 5;
            const LAS unsigned char* kt = kbuf + (tile & 1) * ATILE;
            const LAS unsigned char* vtl = vbuf + (tile & 1) * ATILE;
            const LAS unsigned char* qwl = qbuf + wave * (32 * AQ_STRIDE);
            if (tile + 1 < NCH) att_dma_tile(DK, DV, b, hd, tile + 1, kbuf + ((tile + 1) & 1) * ATILE, vbuf + ((tile + 1) & 1) * ATILE, wave, ln);
#if ATT_WARM
            {
                const int wt = tile + ATT_WARM < NCH ? tile + ATT_WARM : NCH - 1;
                const int wrow = (tl >> 2) & 63, wseg = tl & 3;
                const bf16_t* wsrc = ((tl >> 8) ? DV : DK) + (size_t)att_krow(b, wt, wrow) * DM + hd * 128 + wseg * 32;
                __builtin_amdgcn_global_load_lds((const unsigned*)wsrc, (LAS unsigned*)(lds + 4 * ATILE + 8 * 32 * AQ_STRIDE + wave * 256), 4, 0, 0);
            }
#endif
            const LAS unsigned char* kl = kt + lr * 256;
            const int kx = (lh ^ (lr & 15)) << 4;
            const int vq = (ln & 15) >> 2, vpp = ln & 3, vg1 = (ln >> 4) & 1;
            const LAS unsigned char* vl = vtl + (4 * lh + vq) * 256 + (2 * vg1 + (vpp >> 1)) * 16 + 8 * (vpp & 1);
#if ATT_ASM
            const unsigned kb0 = (unsigned)(size_t)kt + lr * 256, qb0 = (unsigned)(size_t)qwl + lr * AQ_STRIDE + lh * 16;
            const unsigned vb0 = (unsigned)(size_t)vtl + (4 * lh + vq) * 256 + (2 * vg1 + (vpp >> 1)) * 16 + 8 * (vpp & 1);
#define LDS_RD128(dst, addr, off) asm volatile("ds_read_b128 %0, %1 offset:%c2" : "=v"(dst) : "v"(addr), "n"(off))
#define LDS_RDTR(dst, addr, off) asm volatile("ds_read_b64_tr_b16 %0, %1 offset:%c2" : "=v"(dst) : "v"(addr), "n"(off))
#define LDS_WAIT3(n, a, b, c) asm volatile("s_waitcnt lgkmcnt(" #n ")" : "+v"(a), "+v"(b), "+v"(c))
#define LDS_WAIT8(n, a, b, c, d, e, f, g, h) asm volatile("s_waitcnt lgkmcnt(" #n ")" : "+v"(a), "+v"(b), "+v"(c), "+v"(d), "+v"(e), "+v"(f), "+v"(g), "+v"(h))
#define ATT_QK(c, s0, s1) do { bf16x8 k0[4], k1[4], qf[4]; \
                _Pragma("unroll") for (int ks = 0; ks < 4; ++ks) { const unsigned ka = kb0 + (((((c) * 8 + 2 * ks) << 4)) ^ kx); \
                    LDS_RD128(k0[ks], ka, 0); LDS_RD128(k1[ks], ka, 8192); LDS_RD128(qf[ks], qb0, (c) * 128 + 32 * ks); } \
                LDS_WAIT3(9, k0[0], k1[0], qf[0]); \
                s0 = __builtin_amdgcn_mfma_f32_32x32x16_bf16(k0[0], qf[0], s0, 0, 0, 0); s1 = __builtin_amdgcn_mfma_f32_32x32x16_bf16(k1[0], qf[0], s1, 0, 0, 0); \
                LDS_WAIT3(6, k0[1], k1[1], qf[1]); \
                s0 = __builtin_amdgcn_mfma_f32_32x32x16_bf16(k0[1], qf[1], s0, 0, 0, 0); s1 = __builtin_amdgcn_mfma_f32_32x32x16_bf16(k1[1], qf[1], s1, 0, 0, 0); \
                LDS_WAIT3(3, k0[2], k1[2], qf[2]); \
                s0 = __builtin_amdgcn_mfma_f32_32x32x16_bf16(k0[2], qf[2], s0, 0, 0, 0); s1 = __builtin_amdgcn_mfma_f32_32x32x16_bf16(k1[2], qf[2], s1, 0, 0, 0); \
                LDS_WAIT3(0, k0[3], k1[3], qf[3]); \
                s0 = __builtin_amdgcn_mfma_f32_32x32x16_bf16(k0[3], qf[3], s0, 0, 0, 0); s1 = __builtin_amdgcn_mfma_f32_32x32x16_bf16(k1[3], qf[3], s1, 0, 0, 0); } while (0)
#define ATT_VRD(kk, lo, hi) do { _Pragma("unroll") for (int dvb = 0; dvb < 4; ++dvb) { const unsigned va = vb0 + ((dvb ^ vq) << 6); \
                    LDS_RDTR(lo[dvb], va, (kk) * 4096); LDS_RDTR(hi[dvb], va, (kk) * 4096 + 2048); } } while (0)
#define ATT_VMM(c, kk, lo, hi, pf) do { _Pragma("unroll") for (int dvb = 0; dvb < 4; ++dvb) \
                    O[c][dvb] = __builtin_amdgcn_mfma_f32_32x32x16_bf16(cat8(lo[dvb], hi[dvb]), pf[kk], O[c][dvb], 0, 0, 0); } while (0)
#define ATT_PV(c, pf) do { s16x4 la[4], ha[4], lb[4], hb[4]; \
                ATT_VRD(0, la, ha); ATT_VRD(1, lb, hb); \
                LDS_WAIT8(8, la[0], ha[0], la[1], ha[1], la[2], ha[2], la[3], ha[3]); ATT_VMM(c, 0, la, ha, pf); \
                ATT_VRD(2, la, ha); \
                LDS_WAIT8(8, lb[0], hb[0], lb[1], hb[1], lb[2], hb[2], lb[3], hb[3]); ATT_VMM(c, 1, lb, hb, pf); \
                ATT_VRD(3, lb, hb); \
                LDS_WAIT8(8, la[0], ha[0], la[1], ha[1], la[2], ha[2], la[3], ha[3]); ATT_VMM(c, 2, la, ha, pf); \
                LDS_WAIT8(0, lb[0], hb[0], lb[1], hb[1], lb[2], hb[2], lb[3], hb[3]); ATT_VMM(c, 3, lb, hb, pf); } while (0)
#else
#define ATT_KFRAG(r0, cl) (*(const LAS bf16x8*)(kl + (r0) * 256 + ((((cl) << 4)) ^ kx)))
#define ATT_QK(c, s0, s1) do { _Pragma("unroll") for (int ks = 0; ks < 4; ++ks) { \
                const bf16x8 k0 = ATT_KFRAG(0, (c) * 8 + 2 * ks); \
                const bf16x8 k1 = ATT_KFRAG(32, (c) * 8 + 2 * ks); \
                const bf16x8 qfr = row_frag(qwl, AQ_STRIDE, 0, (c) * 64 + 16 * ks, ln); \
                s0 = __builtin_amdgcn_mfma_f32_32x32x16_bf16(k0, qfr, s0, 0, 0, 0); \
                s1 = __builtin_amdgcn_mfma_f32_32x32x16_bf16(k1, qfr, s1, 0, 0, 0); } } while (0)
#endif
#define ATT_SOFTMAX_SAFE(c, s0, s1, pf) do { \
                float ma = max3f(s0[0], s0[1], s1[0]), mb = max3f(s0[2], s0[3], s1[1]); \
                ma = max3f(ma, s1[2], s1[3]); \
                _Pragma("unroll") for (int i = 4; i < 16; i += 4) { ma = max3f(ma, s0[i], s0[i + 1]); mb = max3f(mb, s0[i + 2], s0[i + 3]); ma = max3f(ma, s1[i], s1[i + 1]); mb = max3f(mb, s1[i + 2], s1[i + 3]); } \
                float mt = max3f(ma, mb, mrun[c]); \
                { auto rr = __builtin_amdgcn_permlane32_swap(__float_as_uint(mt), __float_as_uint(mt), false, false); mt = max3f(__uint_as_float(rr[0]), __uint_as_float(rr[1]), mt); } \
                const bool grow = __any(mt > mrun[c] + 8.f);        \
                const float mnew = grow ? mt : mrun[c]; \
                float lsa = 0.f, lsb = 0.f; unsigned pk[16]; \
                _Pragma("unroll") for (int i = 0; i < 8; ++i) { \
                    const float a = __builtin_amdgcn_exp2f(s0[2 * i] - mnew), bb = __builtin_amdgcn_exp2f(s0[2 * i + 1] - mnew); \
                    lsa += a; lsb += bb; pk[i] = pk2(a, bb); \
                    const float cc = __builtin_amdgcn_exp2f(s1[2 * i] - mnew), dd = __builtin_amdgcn_exp2f(s1[2 * i + 1] - mnew); \
                    lsa += cc; lsb += dd; pk[8 + i] = pk2(cc, dd); } \
                if (grow) { \
                    const float alpha = __builtin_amdgcn_exp2f(mrun[c] - mnew); mrun[c] = mnew; lrun[c] *= alpha; \
                    _Pragma("unroll") for (int j = 0; j < 4; ++j) _Pragma("unroll") for (int i = 0; i < 16; ++i) O[c][j][i] *= alpha; } \
                lrun[c] += (lsa + lsb); \
                ATT_EXTRA_VALU(s0, s1) \
                _Pragma("unroll") for (int j = 0; j < 4; ++j) { u32x4 w; w.x = pk[4 * j]; w.y = pk[4 * j + 1]; w.z = pk[4 * j + 2]; w.w = pk[4 * j + 3]; pf[j] = __builtin_bit_cast(bf16x8, w); } } while (0)
#define ATT_SOFTMAX_FAST(c, s0, s1, pf) do { \
                float lsa = 0.f, lsb = 0.f; unsigned pk[16]; \
                _Pragma("unroll") for (int i = 0; i < 8; ++i) { \
                    const float a = __builtin_amdgcn_exp2f(s0[2 * i]), bb = __builtin_amdgcn_exp2f(s0[2 * i + 1]); \
                    lsa += a; lsb += bb; pk[i] = pk2(a, bb); \
                    const float cc = __builtin_amdgcn_exp2f(s1[2 * i]), dd = __builtin_amdgcn_exp2f(s1[2 * i + 1]); \
                    lsa += cc; lsb += dd; pk[8 + i] = pk2(cc, dd); } \
                lrun[c] += (lsa + lsb); \
                _Pragma("unroll") for (int j = 0; j < 4; ++j) { u32x4 w; w.x = pk[4 * j]; w.y = pk[4 * j + 1]; w.z = pk[4 * j + 2]; w.w = pk[4 * j + 3]; pf[j] = __builtin_bit_cast(bf16x8, w); } } while (0)
#define ATT_SOFTMAX(c, s0, s1, pf) do { if constexpr (SAFE) ATT_SOFTMAX_SAFE(c, s0, s1, pf); else ATT_SOFTMAX_FAST(c, s0, s1, pf); } while (0)
#if !ATT_ASM
#define ATT_PV(c, pf) do { _Pragma("unroll") for (int kk = 0; kk < 4; ++kk) _Pragma("unroll") for (int dvb = 0; dvb < 4; ++dvb) { \
                const LAS unsigned char* va = vl + kk * (16 * 256) + ((dvb ^ vq) << 6); \
                const bf16x8 vf = cat8(vtr(va), vtr(va + 8 * 256)); \
                O[c][dvb] = __builtin_amdgcn_mfma_f32_32x32x16_bf16(vf, pf[kk], O[c][dvb], 0, 0, 0); } } while (0)
#endif
#if ATT_SLICE
            if constexpr (!SAFE) {
#define SBAR0() __builtin_amdgcn_sched_barrier(0)
#define ATT_SGB_GROUP() do { _Pragma("unroll") for (int g_ = 0; g_ < 4; ++g_) { __builtin_amdgcn_sched_group_barrier(0x008, 2, 2); __builtin_amdgcn_sched_group_barrier(0x100, 2, 2); __builtin_amdgcn_sched_group_barrier(0x400, 4, 2); __builtin_amdgcn_sched_group_barrier(0x002, 5, 2); } } while (0)
#define ATT_SLICE_SM(src, base, la, lb, pf) do { u32x4 w_; \
                { const float a_ = __builtin_amdgcn_exp2f(src[(base) + 0]), b_ = __builtin_amdgcn_exp2f(src[(base) + 1]); w_.x = pk2(a_, b_); la = fadd1(la, a_, w_.x); lb = fadd1(lb, b_, w_.x); } \
                { const float a_ = __builtin_amdgcn_exp2f(src[(base) + 2]), b_ = __builtin_amdgcn_exp2f(src[(base) + 3]); w_.y = pk2(a_, b_); la = fadd1(la, a_, w_.y); lb = fadd1(lb, b_, w_.y); } \
                { const float a_ = __builtin_amdgcn_exp2f(src[(base) + 4]), b_ = __builtin_amdgcn_exp2f(src[(base) + 5]); w_.z = pk2(a_, b_); la = fadd1(la, a_, w_.z); lb = fadd1(lb, b_, w_.z); } \
                { const float a_ = __builtin_amdgcn_exp2f(src[(base) + 6]), b_ = __builtin_amdgcn_exp2f(src[(base) + 7]); w_.w = pk2(a_, b_); la = fadd1(la, a_, w_.w); lb = fadd1(lb, b_, w_.w); } \
                pf = __builtin_bit_cast(bf16x8, w_); } while (0)
#define ATT_VLOAD(kk, vf) do { _Pragma("unroll") for (int dvb = 0; dvb < 4; ++dvb) { const LAS unsigned char* va = vl + (kk) * (16 * 256) + ((dvb ^ vq) << 6); vf[dvb] = cat8(vtr(va), vtr(va + 8 * 256)); } } while (0)
#define ATT_PVG(c, vf, pf) do { _Pragma("unroll") for (int dvb = 0; dvb < 4; ++dvb) O[c][dvb] = __builtin_amdgcn_mfma_f32_32x32x16_bf16(vf[dvb], pf, O[c][dvb], 0, 0, 0); } while (0)
                f32x16 sa0, sa1, sb0, sb1;
#pragma unroll
                for (int i = 0; i < 16; ++i) { sa0[i] = 0.f; sa1[i] = 0.f; sb0[i] = 0.f; sb1[i] = 0.f; }
                float la0 = 0.f, lb0 = 0.f, la1 = 0.f, lb1 = 0.f;
                bf16x8 pcur, pnxt, vf[4];
#if ATT_SLICE == 2
                bf16x8 p1cur, p1nxt;
                ATT_QK(0, sa0, sa1);
                __builtin_amdgcn_sched_group_barrier(0x100, 12, 0);
                __builtin_amdgcn_sched_group_barrier(0x008, 8, 0);
                SBAR0();
                ATT_QK(1, sb0, sb1);
                ATT_SLICE_SM(sa0, 0, la0, lb0, pcur);
                __builtin_amdgcn_sched_group_barrier(0x100, 12, 1);
#pragma unroll
                for (int g_ = 0; g_ < 8; ++g_) { __builtin_amdgcn_sched_group_barrier(0x008, 1, 1); __builtin_amdgcn_sched_group_barrier(0x002, 3, 1); }
                SBAR0();
                ATT_VLOAD(0, vf);
                ATT_SLICE_SM(sb0, 0, la1, lb1, p1cur);
                SBAR0();
                ATT_PVG(0, vf, pcur); ATT_PVG(1, vf, p1cur); ATT_VLOAD(1, vf); ATT_SLICE_SM(sa0, 8, la0, lb0, pnxt); ATT_SLICE_SM(sb0, 8, la1, lb1, p1nxt); ATT_SGB_GROUP(); SBAR0();
                ATT_PVG(0, vf, pnxt); ATT_PVG(1, vf, p1nxt); ATT_VLOAD(2, vf); ATT_SLICE_SM(sa1, 0, la0, lb0, pcur); ATT_SLICE_SM(sb1, 0, la1, lb1, p1cur); ATT_SGB_GROUP(); SBAR0();
                ATT_PVG(0, vf, pcur); ATT_PVG(1, vf, p1cur); ATT_VLOAD(3, vf); ATT_SLICE_SM(sa1, 8, la0, lb0, pnxt); ATT_SLICE_SM(sb1, 8, la1, lb1, p1nxt); ATT_SGB_GROUP(); SBAR0();
                ATT_PVG(0, vf, pnxt); ATT_PVG(1, vf, p1nxt); SBAR0();
#else
                ATT_QK(0, sa0, sa1);
                SBAR0();
                ATT_QK(1, sb0, sb1);
                ATT_SLICE_SM(sa0, 0, la0, lb0, pcur);
                SBAR0();
                ATT_VLOAD(0, vf);
                ATT_PVG(0, vf, pcur); SBAR0(); ATT_VLOAD(1, vf); ATT_SLICE_SM(sa0, 8, la0, lb0, pnxt); SBAR0();
                ATT_PVG(0, vf, pnxt); SBAR0(); ATT_VLOAD(2, vf); ATT_SLICE_SM(sa1, 0, la0, lb0, pcur); SBAR0();
                ATT_PVG(0, vf, pcur); SBAR0(); ATT_VLOAD(3, vf); ATT_SLICE_SM(sa1, 8, la0, lb0, pnxt); SBAR0();
                ATT_PVG(0, vf, pnxt); SBAR0(); ATT_VLOAD(0, vf); ATT_SLICE_SM(sb0, 0, la1, lb1, pcur); SBAR0();
                ATT_PVG(1, vf, pcur); SBAR0(); ATT_VLOAD(1, vf); ATT_SLICE_SM(sb0, 8, la1, lb1, pnxt); SBAR0();
                ATT_PVG(1, vf, pnxt); SBAR0(); ATT_VLOAD(2, vf); ATT_SLICE_SM(sb1, 0, la1, lb1, pcur); SBAR0();
                ATT_PVG(1, vf, pcur); SBAR0(); ATT_VLOAD(3, vf); ATT_SLICE_SM(sb1, 8, la1, lb1, pnxt); SBAR0();
                ATT_PVG(1, vf, pnxt); SBAR0();
#endif
                lrun[0] += la0 + lb0; lrun[1] += la1 + lb1;
#undef SBAR0
#undef ATT_SGB_GROUP
#undef ATT_SLICE_SM
#undef ATT_VLOAD
#undef ATT_PVG
            } else
#endif
            {
                f32x16 sa0, sa1, sb0, sb1;
#pragma unroll
                for (int i = 0; i < 16; ++i) { sa0[i] = 0.f; sa1[i] = 0.f; sb0[i] = 0.f; sb1[i] = 0.f; }
                bf16x8 pfa[4], pfb[4];
                ATT_QK(0, sa0, sa1);
                if constexpr (!SAFE) __builtin_amdgcn_sched_barrier(0);
#if ATT_PLAN == 1
                ATT_QK(1, sb0, sb1);
                ATT_SOFTMAX(0, sa0, sa1, pfa);
#else
                ATT_SOFTMAX(0, sa0, sa1, pfa);
                if constexpr (!SAFE) __builtin_amdgcn_sched_barrier(0);
                ATT_QK(1, sb0, sb1);
#endif
                if constexpr (!SAFE) __builtin_amdgcn_sched_barrier(0);
                ATT_PV(0, pfa);
                ATT_SOFTMAX(1, sb0, sb1, pfb);
#if ATT_FENCE3
                if constexpr (!SAFE) __builtin_amdgcn_sched_barrier(0);
#endif
                ATT_PV(1, pfb);
                if constexpr (!SAFE) __builtin_amdgcn_sched_barrier(0);
            }
#ifdef ATT_KFRAG
#undef ATT_KFRAG
#endif
#undef ATT_QK
#undef ATT_SOFTMAX
#undef ATT_SOFTMAX_SAFE
#undef ATT_SOFTMAX_FAST
#undef ATT_PV
#if ATT_WARM
            asm volatile("s_waitcnt vmcnt(1) lgkmcnt(0)" ::: "memory");
            __builtin_amdgcn_s_barrier();
            asm volatile("" ::: "memory");
#else
            asm volatile("s_waitcnt vmcnt(0)" ::: "memory");
            __syncthreads();
#endif
        }
#if ATT_WARM
        asm volatile("s_waitcnt vmcnt(0)" ::: "memory");
#endif
        float l0, l1; { auto r0 = __builtin_amdgcn_permlane32_swap(__float_as_uint(lrun[0]), __float_as_uint(lrun[0]), false, false); l0 = __uint_as_float(r0[0]) + __uint_as_float(r0[1]);
          auto r1 = __builtin_amdgcn_permlane32_swap(__float_as_uint(lrun[1]), __float_as_uint(lrun[1]), false, false); l1 = __uint_as_float(r1[0]) + __uint_as_float(r1[1]); }
        if constexpr (!SAFE) {
            const bool bad = !(l0 > 1e-30f && l0 < 1e30f && l1 > 1e-30f && l1 < 1e30f);
            volatile LAS unsigned* badflag = (volatile LAS unsigned*)(lds + LDS_BARST + 16);
            if (bad) *badflag = 1u;
            __syncthreads();
            if (*badflag != 0u) return true;
        }
        const float i0 = 1.f / l0, i1 = lam / l1;
        float ss = 0.f;
#pragma unroll
        for (int j = 0; j < 4; ++j)
#pragma unroll
            for (int i = 0; i < 16; ++i) { const float o = O[0][j][i] * i0 - O[1][j][i] * i1; O[0][j][i] = o; ss += o * o; }
        { auto r0 = __builtin_amdgcn_permlane32_swap(__float_as_uint(ss), __float_as_uint(ss), false, false); ss = __uint_as_float(r0[0]) + __uint_as_float(r0[1]); }
        const float rn = rsqrtf(ss * (1.f / 128.f) + EPSN) * (1.f - LAM_INIT);
        int lnf = lane; asm volatile("" : "+v"(lnf));
        const int hif = lnf >> 5;
        bf16_t* orow = (bf16_t*)(ws + WS_H) + (size_t)(b * SEQL + qb * 256 + wave * 32 + (lnf & 31)) * DM + hd * 128;
        const float* gn = p.in[16] + hd * 128;
#pragma unroll
        for (int j = 0; j < 4; ++j)
#pragma unroll
            for (int g = 0; g < 4; ++g) {
                const int dv = 32 * j + 8 * g + 4 * hif;
                const f32x4 gg = *(const f32x4*)(gn + dv);
                u32x2 w; w.x = pk2(O[0][j][4 * g] * rn * gg.x, O[0][j][4 * g + 1] * rn * gg.y); w.y = pk2(O[0][j][4 * g + 2] * rn * gg.z, O[0][j][4 * g + 3] * rn * gg.w);
                *(u32x2*)(orow + dv) = w;
            }
    return false;
}

__device__ __forceinline__ void phase_attn(const Params& p, LAS unsigned char* lds) {
    const int tid = threadIdx.x, lane = tid & 63, wave = __builtin_amdgcn_readfirstlane(tid >> 6), r32 = lane & 31, hi = lane >> 5;
    unsigned char* ws = p.ws;
    const bf16_t* DQ = (const bf16_t*)(ws + R_DQ); const bf16_t* DK = (const bf16_t*)(ws + R_DK); const bf16_t* DV = (const bf16_t*)(ws + R_DV);
    const float lam = *(const float*)(ws + CTL_LAM);
    LAS unsigned char* kbuf = lds;
    LAS unsigned char* vbuf = lds + 2 * ATILE;
    LAS unsigned char* qbuf = lds + 4 * ATILE;
    static_assert(4 * ATILE + 8 * 32 * AQ_STRIDE + 2048 <= LDS_BARST, "attention LDS");
    const int G = gridDim.x;
    const int nunits = NB * 8 * 32;
#define ATT_UNIT_INDEX(ui, b, hd, qb, stop) do { stop = false; \
        if (G == 256) { if (ui >= 4) { stop = true; b = hd = qb = 0; } else { const int bh = ui * 8 + (blockIdx.x & 7); b = bh >> 3; hd = bh & 7; qb = blockIdx.x >> 3; } }     \
        else { const int it = ui * G + blockIdx.x; if (it >= nunits) { stop = true; b = hd = qb = 0; } else { b = it >> 8; hd = (it >> 5) & 7; qb = it & 31; } } } while (0)
#if ATT_FAST
    unsigned badmask = 0u;
    for (int ui = 0; ui < 32; ++ui) {
        int b, hd, qb; bool stop; ATT_UNIT_INDEX(ui, b, hd, qb, stop); if (stop) break;
        if (att_unit<false>(p, lds, b, hd, qb)) badmask |= 1u << ui;
    }
    if (badmask) {
        for (int ui = 0; ui < 32; ++ui) {
            int b, hd, qb; bool stop; ATT_UNIT_INDEX(ui, b, hd, qb, stop); if (stop) break;
#ifndef ATT_NOFALLBACK
            if ((badmask >> ui) & 1u) { __syncthreads(); att_unit<true>(p, lds, b, hd, qb); }
#endif
        }
    }
#else
    for (int ui = 0;; ++ui) {
        int b, hd, qb; bool stop; ATT_UNIT_INDEX(ui, b, hd, qb, stop); if (stop) break;
        att_unit<true>(p, lds, b, hd, qb);
    }
#endif
#undef ATT_UNIT_INDEX
}

#define XB_TMO      128
#define XB_XCNT(j)  (256  + 64 * (j))
#define XB_XSUB(j)  (1280 + 64 * (j))
#define XB_XGEN(j)  (2304 + 64 * (j))
#define XB_TOP      3328
#define XB_TOPGEN   3392
#define XCD_BAR_WORDS 3456
#define XB_SPIN_CAP (1u << 18)

__device__ __forceinline__ unsigned xb_ld(unsigned* p)              { return __hip_atomic_load(p, __ATOMIC_RELAXED, __HIP_MEMORY_SCOPE_AGENT); }
__device__ __forceinline__ unsigned xb_add(unsigned* p, unsigned v) { return __hip_atomic_fetch_add(p, v, __ATOMIC_RELAXED, __HIP_MEMORY_SCOPE_AGENT); }
__device__ __forceinline__ unsigned xb_xcc_id() { return (unsigned)__builtin_amdgcn_s_getreg((3 << 11) | 20) & 0xFu; }
#define XB_SPIN(cond, bar) do { unsigned _sp = 0; while (cond) { __builtin_amdgcn_s_sleep(1); \
    if ((++_sp & 255u) == 0u) { if (xb_ld(&(bar)[XB_TMO])) break; if (_sp > XB_SPIN_CAP) { atomicAdd(&(bar)[XB_TMO], 1u); break; } } } } while (0)

struct XcdBarrier {
    unsigned* bar; unsigned x;
    volatile LAS unsigned* st;
};

__device__ __forceinline__ XcdBarrier xcd_barrier_post(unsigned* bar, volatile LAS unsigned* st) {
    XcdBarrier b; b.bar = bar; b.x = xb_xcc_id(); b.st = st;
    if (threadIdx.x == 0) (void)xb_add(&bar[XB_XCNT(b.x)], 1u);
    return b;
}
__device__ __forceinline__ void xcd_barrier_complete(unsigned* bar, unsigned x, unsigned& nloc, unsigned& nx) {
    const unsigned G = gridDim.x * gridDim.y * gridDim.z;
    unsigned sum, cnt, mine, sp = 0u;
    for (;;) {
        sum = 0u; cnt = 0u; mine = 0u;
#pragma unroll
        for (unsigned j = 0; j < 16; ++j) { const unsigned c = xb_ld(&bar[XB_XCNT(j)]); sum += c; cnt += (c > 0u) ? 1u : 0u; mine = (j == x) ? c : mine; }
        if (sum == G) break;
        __builtin_amdgcn_s_sleep(1);
        if ((++sp & 255u) == 0u) { if (xb_ld(&bar[XB_TMO])) break; if (sp > XB_SPIN_CAP) { atomicAdd(&bar[XB_TMO], 1u); break; } }
    }
    nloc = mine > 0u ? mine : 1u; nx = cnt > 0u ? cnt : 1u;
}

__device__ __forceinline__ void xcd_barrier(const XcdBarrier& b) {
    asm volatile("s_waitcnt vmcnt(0)" ::: "memory");
    __syncthreads();
    if (threadIdx.x == 0) {
        unsigned* bar = b.bar;
        __builtin_amdgcn_s_waitcnt(0);
        unsigned nloc = b.st[0], nx = b.st[1];
        if (nloc == 0u) { xcd_barrier_complete(bar, b.x, nloc, nx); b.st[0] = nloc; b.st[1] = nx; }
        const unsigned old = xb_add(&bar[XB_XSUB(b.x)], 1u);
        const unsigned gen = old / nloc;
        if (old + 1u == (gen + 1u) * nloc) {
            __builtin_amdgcn_fence(__ATOMIC_RELEASE, "agent");
            asm volatile("s_waitcnt vmcnt(0)" ::: "memory");
            const unsigned og = xb_add(&bar[XB_TOP], 1u);
            const unsigned tg = og / nx;
            if (og + 1u == (tg + 1u) * nx) xb_add(&bar[XB_TOPGEN], 1u);
            else XB_SPIN(xb_ld(&bar[XB_TOPGEN]) == tg, bar);
            __builtin_amdgcn_fence(__ATOMIC_ACQUIRE, "agent");
            xb_add(&bar[XB_XGEN(b.x)], 1u);
            asm volatile("s_waitcnt vmcnt(0)" ::: "memory");
        } else {
            XB_SPIN(xb_ld(&bar[XB_XGEN(b.x)]) == gen, bar);
            __builtin_amdgcn_fence(__ATOMIC_ACQUIRE, "agent");
            asm volatile("s_waitcnt vmcnt(0)" ::: "memory");
        }
    }
    __syncthreads();
}

constexpr int NPHASES = 21;
struct DownOrder {
    static constexpr bool SPLITK = true;
    pg8::StaticOrder lat; int G, c;
    __device__ void init(int G_, int c_) { lat.init(LROWS, DM, G_, c_); G = G_; c = c_; }
    __device__ bool next(int i, pg8::Unit& u) const {
        const long L = (long)i * G + c;
        if (L < 512) { lat.next(i, u); u.kb = 0; u.nt = DFF / 64; return true; }
        const int j = (int)L - 512; if (j >= 176) return false;
        const int tile = j / 11, ks = j % 11;
        u.pm = LROWS / 256 + (tile >> 2); u.pn = tile & 3; u.kb = ks * 4; u.nt = 4; return true;
    }
    __device__ __forceinline__ void a_ready(const pg8::Unit&) const {}
    __device__ __forceinline__ void done(const pg8::Unit&) const {}
};
__device__ __forceinline__ void run_gemm_down1(LAS unsigned char* lds, const Params& p, const bf16_t* A, const bf16_t* Bt) {
    __syncthreads();
    pg8::Gemm g{A, Bt, MROWS, DM, DFF};
    Epi<EPI_RESID_SPLIT> E{}; E.gate_i = 2; E.gscale = 0.5f; E.wsp = p.ws; E.outp = p.out; E.xp = p.in[0]; E.ctxp = p.in[2];
    DownOrder S; S.init((int)gridDim.x, (int)blockIdx.x);
    pg8::gemm_phase<Epi<EPI_RESID_SPLIT>, DownOrder, true, true>(lds, g, S, E);
}
template <int MODE>
__device__ __forceinline__ void run_gemm(LAS unsigned char* lds, const Params& p, const bf16_t* A, const bf16_t* Bt, int M, int N, int K, int gate_i, float gscale) {
    __syncthreads();
    pg8::Gemm g{A, Bt, M, N, K};
    Epi<MODE> E{}; E.gate_i = gate_i; E.gscale = gscale; E.wsp = p.ws; E.outp = p.out; E.xp = p.in[0]; E.ctxp = p.in[2];
    pg8::StaticOrder S; S.init(M, N, (int)gridDim.x, (int)blockIdx.x);
    pg8::gemm_phase<Epi<MODE>, pg8::StaticOrder, true, true>(lds, g, S, E);
}
__global__ void __launch_bounds__(512, 2) fwd_megakernel(Params p) {
    extern __shared__ __attribute__((aligned(16))) unsigned char lds_raw[];
    LAS unsigned char* lds = (LAS unsigned char*)lds_raw;
    unsigned char* ws = p.ws;
    const float* MOD = (const float*)(ws + CTL_MOD);
    bf16_t* H = (bf16_t*)(ws + WS_H);
    const int lo = p.ph_lo, hi = p.ph_hi;
#define IN(k) (lo <= (k) && (k) < hi)
    volatile LAS unsigned* bst = (volatile LAS unsigned*)(lds + LDS_BARST);
    if (threadIdx.x == 0) { bst[0] = 0u; bst[1] = 0u; }
    __syncthreads();
    XcdBarrier xb; xb.bar = (unsigned*)(ws + CTL_BAR); xb.x = 0; xb.st = bst;
    if (hi - lo > 1) xb = xcd_barrier_post((unsigned*)(ws + CTL_BAR), bst);
#define SEAM(k) do { if (IN(k) && IN((k) + 1)) { if (SEAM0_CG && (k) == 0) cg::this_grid().sync(); else xcd_barrier(xb); } } while (0)
    if (lo > 1000) cg::this_grid().sync();
#ifndef NO_PREP
    if (IN(0)) phase_prep(p, lds);
#endif
    SEAM(0);
    if (IN(1)) { phase_modnorm(p.in[0], p.in[2], MROWS, p.in[6], MOD, 0, 1, H); phase_wcopy(p, lds); }
    SEAM(1);
#ifndef NO_GEMM
    if (IN(2)) run_gemm<EPI_SWIGLU>(lds, p, H, (const bf16_t*)(ws + W_W13A), MROWS, 2 * DFF, DM, 0, 0.f);
    SEAM(2);
#if SPLITK_DOWN1
    if (IN(3)) run_gemm_down1(lds, p, (const bf16_t*)(ws + R_U), (const bf16_t*)(ws + W_W2A));
#else
    if (IN(3)) run_gemm<EPI_RESID>(lds, p, (const bf16_t*)(ws + R_U), (const bf16_t*)(ws + W_W2A), MROWS, DM, DFF, 2, 0.5f);
#endif
#endif
    SEAM(3);
#if SPLITK_DOWN1
    if (IN(4)) phase_modnorm(p.out, p.in[2], MROWS, p.in[10], MOD, 3, 4, H, (const float*)(ws + WS_R + R_PART_OFF * MiB));
#else
    if (IN(4)) phase_modnorm(p.out, (const float*)(ws + R_XC1), MROWS, p.in[10], MOD, 3, 4, H);
#endif
    SEAM(4);
#ifndef NO_GEMM
    if (IN(5)) run_gemm<EPI_WINA>(lds, p, H, (const bf16_t*)(ws + W_WINA), MROWS, NWIN_A, DM, 0, 0.f);
#endif
    SEAM(5);
#ifndef NO_GLAA
    if (IN(6)) phase_gla_a(p, lds, 0);
#endif
    SEAM(6);
#ifndef NO_SCAN
    if (IN(7)) phase_gla_scan(p);
#endif
    SEAM(7);
#ifndef NO_GLAC
    if (IN(8)) phase_gla_c(p, lds, 0);
#endif
    SEAM(8);
#ifndef NO_GLAA
    if (IN(9)) phase_gla_a(p, lds, 1);
#endif
    SEAM(9);
#ifndef NO_SCAN
    if (IN(10)) phase_gla_scan(p);
#endif
    SEAM(10);
#ifndef NO_GLAC
    if (IN(11)) phase_gla_c(p, lds, 1);
#endif
    SEAM(11);
#ifndef NO_GEMM
    if (IN(12)) run_gemm<EPI_WINB>(lds, p, H, (const bf16_t*)(ws + W_WINB), MROWS, NWIN_B, DM, 0, 0.f);
#endif
    SEAM(12);
#ifndef NO_ATTN
    if (IN(13)) phase_attn(p, lds);
#endif
    SEAM(13);
#ifndef NO_GEMM
    if (IN(14)) run_gemm<EPI_MERGE1>(lds, p, (const bf16_t*)(ws + WS_GG), (const bf16_t*)(ws + W_WBG), LROWS, DM, DM, 0, 0.f);
    SEAM(14);
    if (IN(15)) run_gemm<EPI_MERGE2>(lds, p, (const bf16_t*)(ws + WS_H), (const bf16_t*)(ws + W_WBD), LROWS, DM, DM, 0, 0.f);
    SEAM(15);
    if (IN(16)) run_gemm<EPI_RESID>(lds, p, (const bf16_t*)(ws + R_GA), (const bf16_t*)(ws + W_WOUT), LROWS, DM, DM, 5, 1.0f);
#endif
    SEAM(16);
    if (IN(17)) phase_modnorm(p.out, p.out, LROWS, p.in[20], MOD, 6, 7, H);
    SEAM(17);
#ifndef NO_GEMM
    if (IN(18)) run_gemm<EPI_SWIGLU>(lds, p, H, (const bf16_t*)(ws + W_W13B), LROWS, 2 * DFF, DM, 0, 0.f);
    SEAM(18);
    if (IN(19)) run_gemm<EPI_RESID>(lds, p, (const bf16_t*)(ws + R_U), (const bf16_t*)(ws + W_W2B), LROWS, DM, DFF, 8, 0.5f);
#endif
    SEAM(19);
    if (IN(20)) phase_finalnorm(p.out, p.in[24]);
#ifdef MK_GLA_PROBE
    if (IN(106)) phase_gla_a(p, lds, 0);
    if (IN(107)) phase_gla_scan(p);
    if (IN(108)) phase_gla_c(p, lds, 0, true);
#endif
#ifdef MK_DUMPF
    if (IN(100)) { const float* src = (const float*)(ws + (MK_DUMPF)); for (size_t i = (size_t)blockIdx.x * 512 + threadIdx.x; i < (size_t)LROWS * DM; i += (size_t)gridDim.x * 512) p.out[i] = src[i % (size_t)(MK_DUMPF_N)]; }
#elif defined(MK_DUMP)
    if (IN(100)) { const bf16_t* src = (const bf16_t*)(ws + (MK_DUMP)); for (size_t i = (size_t)blockIdx.x * 512 + threadIdx.x; i < (size_t)LROWS * DM; i += (size_t)gridDim.x * 512) p.out[i] = bf2f(src[i]); }
#endif
#undef IN
#undef SEAM
}

#ifndef MK_ONE_LAUNCH
#define MK_ONE_LAUNCH 0
#endif
#ifndef MK_REP_N
#define MK_REP_N 1
#endif
#ifndef MK_REP_PH2
#define MK_REP_PH2 -1
#endif
extern "C" void kernel_launch(void* const* d_in, const int* in_sizes, int n_in, void* d_out, int out_size, void* d_ws, size_t ws_size, hipStream_t stream) {
    static int grid = 0;
    if (grid == 0) {
        if (n_in != 25 || out_size != LROWS * DM || ws_size < WS_END) { fprintf(stderr, "kernel_launch: unexpected problem (n_in %d out %d ws %zu, need ws >= %zu); nothing launched\n", n_in, out_size, ws_size, (size_t)WS_END); grid = -1; return; }
        int dev = 0, cus = 0, per_cu = 0;
        if (hipGetDevice(&dev) != hipSuccess || hipDeviceGetAttribute(&cus, hipDeviceAttributeMultiprocessorCount, dev) != hipSuccess) { fprintf(stderr, "kernel_launch: device query failed\n"); grid = -1; return; }
        if (hipFuncSetAttribute((const void*)fwd_megakernel, hipFuncAttributeMaxDynamicSharedMemorySize, LDS_BYTES) != hipSuccess) { fprintf(stderr, "kernel_launch: hipFuncSetAttribute failed\n"); grid = -1; return; }
        if (hipOccupancyMaxActiveBlocksPerMultiprocessor(&per_cu, (const void*)fwd_megakernel, 512, LDS_BYTES) != hipSuccess || per_cu < 1) { fprintf(stderr, "kernel_launch: occupancy query says %d blocks per CU\n", per_cu); per_cu = 1; }
        (void)hipGetLastError();
        grid = cus * (per_cu > 1 ? 1 : per_cu);
        fprintf(stderr, "kernel_launch: grid %d (cus %d, per_cu %d), ws %zu\n", grid, cus, per_cu, ws_size);
    }
    if (grid < 0) return;
#if MK_ONE_LAUNCH
    if (hipMemsetAsync((char*)d_ws + CTL_BAR, 0, 16384, stream) != hipSuccess) { fprintf(stderr, "kernel_launch: memset failed\n"); return; }
#endif
    Params p{};
    for (int i = 0; i < 25; ++i) p.in[i] = (const float*)d_in[i];
    p.out = (float*)d_out; p.ws = (unsigned char*)d_ws;
#if MK_ONE_LAUNCH
    p.ph_lo = 0; p.ph_hi = NPHASES;
    void* args[] = {&p};
    hipError_t e = hipLaunchCooperativeKernel((const void*)fwd_megakernel, dim3(grid), dim3(512), args, LDS_BYTES, stream);
    if (e != hipSuccess) fprintf(stderr, "kernel_launch: cooperative launch failed: %s (grid %d)\n", hipGetErrorString(e), grid);
#else
#ifndef MK_STOP_AFTER
#define MK_STOP_AFTER (NPHASES - 1)
#endif
    for (int ph = 0; ph <= MK_STOP_AFTER; ++ph) {
#ifdef MK_SKIP_LO
        if (ph >= MK_SKIP_LO && ph <= MK_SKIP_HI) continue;
#endif
#ifdef MK_GLA_PROBE
        if (ph == 6) for (int r = 0; r < MK_GLA_PROBE; ++r) for (int q = 106; q <= 108; ++q) { p.ph_lo = q; p.ph_hi = q + 1; hipLaunchKernelGGL(fwd_megakernel, dim3(grid), dim3(512), LDS_BYTES, stream, p); }
#endif
        p.ph_lo = ph; p.ph_hi = ph + 1;
        hipLaunchKernelGGL(fwd_megakernel, dim3(grid), dim3(512), LDS_BYTES, stream, p);
#ifdef MK_REP_PH
        if (ph == MK_REP_PH || ph == MK_REP_PH2) for (int r = 0; r < MK_REP_N; ++r) hipLaunchKernelGGL(fwd_megakernel, dim3(grid), dim3(512), LDS_BYTES, stream, p);
#endif
    }
#if defined(MK_DUMP) || defined(MK_DUMPF)
    { p.ph_lo = 100; p.ph_hi = 101; hipLaunchKernelGGL(fwd_megakernel, dim3(grid), dim3(512), LDS_BYTES, stream, p); }
#endif
#endif
}
```

```cpp
#define MK_ONE_LAUNCH 1
#define ATT_PLAN 2
#define ATT_SLICE 2
#define SPLITK_DOWN1 1
#include <hip/hip_runtime.h>
#include <hip/hip_cooperative_groups.h>
#include <cstdio>
#include <cstdint>
namespace cg = cooperative_groups;
namespace pg8 {
#define PG8_LAS __attribute__((address_space(3)))
typedef unsigned short bf16_t;
typedef short bf16x8 __attribute__((ext_vector_type(8)));
typedef float f32x4 __attribute__((ext_vector_type(4)));
typedef unsigned u32x4 __attribute__((ext_vector_type(4)));
constexpr int BM = 256, BK = 64, HALF = 128, HTB = HALF * BK * 2  , STAGE_BYTES = 8 * HTB, NXCD = 8, WGM = 8;

__host__ __device__ __forceinline__ int lds_byte(int r, int c) { const int st = (r >> 4) * 2 + (c >> 5), rr = r & 15, cc = c & 31, ob = rr * 64 + cc * 2; return st * 1024 + (ob ^ (((ob >> 9) & 1) << 5)); }
__host__ __device__ __forceinline__ void stage_rc(int b, int& R, int& C) { const int st = b / 1024, sb = b % 1024, swz = sb ^ (((sb >> 9) & 1) << 5); R = (st >> 1) * 16 + swz / 64; C = (st & 1) * 32 + (swz % 64) / 2; }
__host__ __device__ __forceinline__ int perm32(int rho) { const int n = rho >> 4, i = rho & 15; return 8 * (i >> 2) + 4 * n + (i & 3); }

struct Unit { int pm, pn, kb, nt; };
struct Gemm { const bf16_t* A; const bf16_t* Bt; int M, N, K; };

struct StaticOrder {
    static constexpr bool SPLITK = false;
    int nM, nN, nwg, G, c;
    __host__ __device__ void init(int M, int N, int G_, int c_) { nM = M / BM; nN = N / BM; nwg = nM * nN; G = G_; c = c_; }
    __host__ __device__ bool next(int i, Unit& u) const {
        const long L = (long)i * G + c; if (L >= nwg) return false;
        int wgid = (int)L; { const int q = nwg / NXCD, r = nwg % NXCD, xcd = wgid % NXCD, off = wgid / NXCD; wgid = (xcd < r ? xcd * (q + 1) : r * (q + 1) + (xcd - r) * q) + off; }
        const int nig = WGM * nN, gid = wgid / nig, fm = gid * WGM, gsz = (nM - fm) < WGM ? (nM - fm) : WGM;
        u.pm = fm + ((wgid % nig) % gsz); u.pn = (wgid % nig) / gsz; return true;
    }
    __device__ __forceinline__ void a_ready(const Unit&) const {}
    __device__ __forceinline__ void done(const Unit&) const {}
};

__device__ __forceinline__ unsigned cvt_pk_bf16(float lo, float hi) { unsigned r; asm volatile("v_cvt_pk_bf16_f32 %0, %1, %2" : "=v"(r) : "v"(lo), "v"(hi)); return r; }
typedef float f32x2 __attribute__((ext_vector_type(2)));
template <class Epi, class Sched, bool ALIGN_EPI = false, bool SP2 = false>
__device__ __forceinline__ void gemm_phase(PG8_LAS unsigned char* lds, const Gemm g, const Sched& S, const Epi& E) {
    const int tid = threadIdx.x, wid = __builtin_amdgcn_readfirstlane(tid >> 6), lane = tid & 63, wr = wid >> 2, wc = wid & 3, fr = lane & 15, fq = lane >> 4;
    const int K = g.K; int nt = K / BK;
    unsigned voffA[2], voffB[2];
#pragma unroll
    for (int i = 0; i < 2; ++i) { int R, C; stage_rc(tid * 16 + i * 8192, R, C); const int Rb = Epi::PERM ? ((R & ~31) + perm32(R & 31)) : R;
        voffA[i] = (unsigned)(R * K + C) * 2u; voffB[i] = (unsigned)(Rb * K + C) * 2u; }
    const size_t kstep = (size_t)(BK * 2);
    const size_t hstep = (size_t)HALF * K * 2;
    const size_t tstep = 2 * hstep;
    const unsigned ldsw = (unsigned)wid * 1024u;
    const int aoff = lds_byte(wr * 64 + fr, fq * 8), boff = lds_byte(wc * 32 + fr, fq * 8);
#define PG8_SA(b, h) (((b) * 2 + (h)) * HTB)
#define PG8_SB(b, h) ((4 + (b) * 2 + (h)) * HTB)
#define PG8_STAGE(bufoff, gbase, voff) do { _Pragma("unroll") for (int _i = 0; _i < 2; ++_i) \
        __builtin_amdgcn_global_load_lds((const unsigned*)((const char*)(gbase) + (voff)[_i]), (PG8_LAS unsigned*)(lds + (bufoff) + ldsw + _i * 8192), 16, 0, 0); } while (0)
#define PG8_LDA(dst, b, h) do { _Pragma("unroll") for (int m = 0; m < 4; ++m) _Pragma("unroll") for (int k = 0; k < 2; ++k) dst[m][k] = *(const PG8_LAS bf16x8*)(lds + PG8_SA(b, h) + aoff + m * 2048 + k * 1024); } while (0)
#define PG8_LDB(dst, b, h) do { _Pragma("unroll") for (int n = 0; n < 2; ++n) _Pragma("unroll") for (int k = 0; k < 2; ++k) dst[n][k] = *(const PG8_LAS bf16x8*)(lds + PG8_SB(b, h) + boff + n * 2048 + k * 1024); } while (0)
#define PG8_MMA(ai, bj, At, Bt) do { __builtin_amdgcn_s_setprio(1); _Pragma("unroll") for (int m = 0; m < 4; ++m) _Pragma("unroll") for (int n = 0; n < 2; ++n) _Pragma("unroll") for (int k = 0; k < 2; ++k) \
        acc[ai][bj][m][n] = __builtin_amdgcn_mfma_f32_16x16x32_bf16(Bt[n][k], At[m][k], acc[ai][bj][m][n], 0, 0, 0); __builtin_amdgcn_s_setprio(0); } while (0)
#define PG8_WAIT_V(n) asm volatile("s_waitcnt vmcnt(" #n ")" ::: "memory")
#define PG8_WAIT_L(n) asm volatile("s_waitcnt lgkmcnt(" #n ")" ::: "memory")
#define PG8_BAR __builtin_amdgcn_s_barrier()
#define PG8_SCHED __builtin_amdgcn_sched_barrier(0)
    Unit cur, nxt; int ui = 0;
    if (!S.next(0, cur)) return;
    if constexpr (Sched::SPLITK) nt = cur.nt;
    f32x4 acc[2][2][4][2];
#pragma unroll
    for (int a = 0; a < 2; ++a)
#pragma unroll
        for (int b = 0; b < 2; ++b)
#pragma unroll
            for (int m = 0; m < 4; ++m)
#pragma unroll
                for (int n = 0; n < 2; ++n) acc[a][b][m][n] = (f32x4){0.f, 0.f, 0.f, 0.f};
    bf16x8 At[4][2], B0[2][2], B1[2][2];
    const char* cA = (const char*)g.A + (size_t)cur.pm * tstep; const char* cB = (const char*)g.Bt + (size_t)cur.pn * tstep;
    if constexpr (Sched::SPLITK) { cA += (size_t)cur.kb * kstep; cB += (size_t)cur.kb * kstep; }
    S.a_ready(cur);
    if constexpr (SP2) {
        PG8_STAGE(PG8_SB(0, 0), cB, voffB); PG8_STAGE(PG8_SB(0, 1), cB + hstep, voffB); PG8_STAGE(PG8_SA(0, 0), cA, voffA); PG8_STAGE(PG8_SA(0, 1), cA + hstep, voffA);
        if (wr == 1) PG8_BAR;
        PG8_WAIT_V(2); PG8_BAR;
        PG8_STAGE(PG8_SB(1, 0), cB + kstep, voffB); PG8_STAGE(PG8_SA(1, 0), cA + kstep, voffA); PG8_STAGE(PG8_SB(1, 1), cB + hstep + kstep, voffB);
        PG8_WAIT_V(6); PG8_BAR;
    } else {
        PG8_STAGE(PG8_SB(0, 0), cB, voffB); PG8_STAGE(PG8_SA(0, 0), cA, voffA); PG8_STAGE(PG8_SB(0, 1), cB + hstep, voffB); PG8_STAGE(PG8_SA(0, 1), cA + hstep, voffA);
        if (wr == 1) PG8_BAR;
        PG8_WAIT_V(4); PG8_BAR;
        PG8_STAGE(PG8_SB(1, 0), cB + kstep, voffB); PG8_STAGE(PG8_SA(1, 0), cA + kstep, voffA); PG8_STAGE(PG8_SB(1, 1), cB + hstep + kstep, voffB);
        PG8_WAIT_V(6); PG8_BAR;
    }
    for (;;) {
        const bool has_next = S.next(ui + 1, nxt);
        const char* nA = has_next ? (const char*)g.A + (size_t)nxt.pm * tstep : cA; const char* nB = has_next ? (const char*)g.Bt + (size_t)nxt.pn * tstep : cB;
        if constexpr (Sched::SPLITK) { if (has_next) { nA += (size_t)nxt.kb * kstep; nB += (size_t)nxt.kb * kstep; } }
        for (int t = 0; t < nt; t += 2) {
            const bool last = (t == nt - 2);
            const char* a1 = cA + (size_t)(t + 1) * kstep;
            const char* a2 = last ? nA : cA + (size_t)(t + 2) * kstep; const char* b2 = last ? nB : cB + (size_t)(t + 2) * kstep;
            const char* a3 = a2 + kstep; const char* b3 = b2 + kstep;
            if (last && has_next) S.a_ready(nxt);
            if constexpr (SP2) {
            PG8_LDB(B0, 0, 0); PG8_LDB(B1, 0, 1); PG8_SCHED; PG8_LDA(At, 0, 0); PG8_STAGE(PG8_SA(1, 1), a1 + hstep, voffA);
            PG8_WAIT_V(8); PG8_WAIT_L(0); PG8_BAR; PG8_MMA(0, 0, At, B0); PG8_MMA(0, 1, At, B1); PG8_BAR; PG8_SCHED;
            PG8_LDA(At, 0, 1); PG8_STAGE(PG8_SB(0, 0), b2, voffB); PG8_STAGE(PG8_SB(0, 1), b2 + hstep, voffB); PG8_STAGE(PG8_SA(0, 0), a2, voffA);
            PG8_WAIT_V(8); PG8_WAIT_L(0); PG8_BAR; PG8_MMA(1, 0, At, B0); PG8_MMA(1, 1, At, B1); PG8_BAR; PG8_SCHED;
            PG8_LDB(B0, 1, 0); PG8_LDB(B1, 1, 1); PG8_SCHED; PG8_LDA(At, 1, 0); PG8_STAGE(PG8_SA(0, 1), a2 + hstep, voffA);
            PG8_WAIT_V(8); PG8_WAIT_L(0); PG8_BAR; PG8_MMA(0, 0, At, B0); PG8_MMA(0, 1, At, B1); PG8_BAR; PG8_SCHED;
            PG8_LDA(At, 1, 1); PG8_STAGE(PG8_SB(1, 0), b3, voffB); PG8_STAGE(PG8_SB(1, 1), b3 + hstep, voffB); PG8_STAGE(PG8_SA(1, 0), a3, voffA);
            PG8_WAIT_V(8); PG8_WAIT_L(0); PG8_BAR; PG8_MMA(1, 0, At, B0); PG8_MMA(1, 1, At, B1); PG8_BAR; PG8_SCHED;
            } else {
            PG8_LDB(B0, 0, 0); PG8_SCHED; PG8_LDA(At, 0, 0); PG8_STAGE(PG8_SA(1, 1), a1 + hstep, voffA);
            PG8_WAIT_L(8); PG8_BAR; PG8_WAIT_L(0); PG8_MMA(0, 0, At, B0); PG8_BAR; PG8_SCHED;
            PG8_LDB(B1, 0, 1); PG8_STAGE(PG8_SB(0, 0), b2, voffB);
            PG8_BAR; PG8_WAIT_L(0); PG8_MMA(0, 1, At, B1); PG8_BAR;
            PG8_LDA(At, 0, 1); PG8_STAGE(PG8_SA(0, 0), a2, voffA);
            PG8_BAR; PG8_WAIT_L(0); PG8_MMA(1, 0, At, B0); PG8_BAR; PG8_SCHED;
            PG8_STAGE(PG8_SB(0, 1), b2 + hstep, voffB);
            PG8_WAIT_V(6); PG8_BAR; PG8_MMA(1, 1, At, B1); PG8_BAR;
            PG8_LDB(B0, 1, 0); PG8_SCHED; PG8_LDA(At, 1, 0); PG8_STAGE(PG8_SA(0, 1), a2 + hstep, voffA);
            PG8_WAIT_L(8); PG8_BAR; PG8_WAIT_L(0); PG8_MMA(0, 0, At, B0); PG8_BAR; PG8_SCHED;
            PG8_LDB(B1, 1, 1); PG8_STAGE(PG8_SB(1, 0), b3, voffB);
            PG8_BAR; PG8_WAIT_L(0); PG8_MMA(0, 1, At, B1); PG8_BAR;
            PG8_LDA(At, 1, 1); PG8_STAGE(PG8_SA(1, 0), a3, voffA);
            PG8_BAR; PG8_WAIT_L(0); PG8_MMA(1, 0, At, B0); PG8_BAR; PG8_SCHED;
            PG8_STAGE(PG8_SB(1, 1), b3 + hstep, voffB);
            PG8_WAIT_V(6); PG8_BAR; PG8_MMA(1, 1, At, B1); PG8_BAR;
            }
        }
        if constexpr (ALIGN_EPI) { if (wr == 0) PG8_BAR; }
        if constexpr (!Epi::AFTER_DRAIN) { E(acc, cur, wr, wc, fr, fq); S.done(cur); }
        if (!has_next) break;
#pragma unroll
        for (int a = 0; a < 2; ++a)
#pragma unroll
            for (int b = 0; b < 2; ++b)
#pragma unroll
                for (int m = 0; m < 4; ++m)
#pragma unroll
                    for (int n = 0; n < 2; ++n) acc[a][b][m][n] = (f32x4){0.f, 0.f, 0.f, 0.f};
        cur = nxt; cA = nA; cB = nB; ++ui;
        if constexpr (Sched::SPLITK) nt = cur.nt;
        if constexpr (ALIGN_EPI) { if (wr == 1) PG8_BAR; }
    }
    PG8_WAIT_V(0);
    if constexpr (!ALIGN_EPI) { if (wr == 0) PG8_BAR; }
    PG8_BAR;
    if constexpr (Epi::AFTER_DRAIN) { E.fused(acc, cur, wr, wc, fr, fq, lds, wid, lane); S.done(cur); }
#undef PG8_SA
#undef PG8_SB
#undef PG8_STAGE
#undef PG8_LDA
#undef PG8_LDB
#undef PG8_MMA
#undef PG8_WAIT_V
#undef PG8_WAIT_L
#undef PG8_BAR
#undef PG8_SCHED
}
}

#define LAS __attribute__((address_space(3)))
typedef unsigned short bf16_t;
typedef short bf16x8 __attribute__((ext_vector_type(8)));
typedef short s16x4 __attribute__((ext_vector_type(4)));
typedef float f32x4 __attribute__((ext_vector_type(4)));
typedef float f32x16 __attribute__((ext_vector_type(16)));
typedef unsigned u32x4 __attribute__((ext_vector_type(4)));
typedef unsigned u32x2 __attribute__((ext_vector_type(2)));

constexpr int DM = 1024, NB = 4, SEQL = 8192, NCTX = 256, DFF = 2816;
constexpr int LROWS = NB * SEQL, CROWS = NB * NCTX, MROWS = LROWS + CROWS;
constexpr int NMODC = 9 * DM;
constexpr float EPSN = 1e-6f;
constexpr int NWIN_A = 3328, NWIN_B = 5120;
constexpr int NCH = 132;
constexpr float QSCALE_GLA = 0.08838834764831845f;
constexpr float C2ATT = 0.125f * 1.4426950408889634f;
constexpr float LAM_INIT = 0.2f;

constexpr size_t MiB = 1u << 20;
constexpr size_t WS_CTL = 0;
constexpr size_t CTL_MOD = 0;
constexpr size_t CTL_LAM = 256 * 1024;
constexpr size_t CTL_ROPE = 320 * 1024;
constexpr size_t CTL_BAR = 512 * 1024;
constexpr size_t WS_W = 1 * MiB;
constexpr size_t W_WINA = WS_W;
constexpr size_t W_WINB = W_WINA + (size_t)NWIN_A * DM * 2;
constexpr size_t W_WBG = W_WINB + (size_t)NWIN_B * DM * 2;
constexpr size_t W_WBD = W_WBG + (size_t)DM * DM * 2;
constexpr size_t W_WOUT = W_WBD + (size_t)DM * DM * 2;
constexpr size_t W_W13B = W_WOUT + (size_t)DM * DM * 2;
constexpr size_t W_W2B = W_W13B + (size_t)2 * DFF * DM * 2;
constexpr size_t W_W13A = W_W2B + (size_t)DM * DFF * 2;
constexpr size_t W_W2A = W_W13A + (size_t)2 * DFF * DM * 2;
constexpr size_t WS_H = W_W2A + (size_t)DM * DFF * 2;
static_assert(WS_H == 1 * MiB + 58195968, "weights");
constexpr size_t WS_GG = WS_H + (size_t)MROWS * DM * 2;
constexpr size_t WS_R = WS_GG + (size_t)LROWS * DM * 2;
constexpr size_t R_U = WS_R;
constexpr size_t R_XC1 = WS_R + (size_t)MROWS * DFF * 2;
constexpr size_t R_GQ = WS_R;
constexpr size_t R_GK = WS_R + 32 * MiB;
constexpr size_t R_GV = WS_R + 65 * MiB;
constexpr size_t R_LR = WS_R + 131 * MiB;
constexpr size_t R_DEC = WS_R + 136 * MiB;
constexpr size_t R_S = WS_R + 186 * MiB;
constexpr size_t R_DQ = WS_R;
constexpr size_t R_DK = WS_R + 64 * MiB;
constexpr size_t R_DV = WS_R + 130 * MiB;
constexpr size_t R_GA = WS_R + 196 * MiB;
constexpr size_t R_GB = WS_R + 260 * MiB;
constexpr size_t WS_END = WS_R + 324 * MiB;
static_assert(R_XC1 + 4 * MiB <= R_S && R_XC1 >= R_DEC + 2 * MiB, "XC1 placement");
static_assert(WS_END <= 512 * MiB, "workspace must fit 512 MiB");

#ifndef ATT_PLAN
#define ATT_PLAN 2
#endif
#ifndef ATT_WARM
#define ATT_WARM 0
#endif
#ifndef ATT_FAST
#define ATT_FAST 1
#endif
#ifndef SPLITK_DOWN1
#define SPLITK_DOWN1 0
#endif
#ifndef ATT_SLICE
#define ATT_SLICE 0
#endif
#ifndef SEAM0_CG
#define SEAM0_CG 1
#endif
#ifndef ATT_FENCE3
#define ATT_FENCE3 1
#endif
#ifndef ATT_ASM
#define ATT_ASM 0
#endif
#ifdef ATT_XVALU
#define ATT_EXTRA_VALU(s0, s1) { float dm = 0.f; _Pragma("unroll") for (int i = 0; i < 16; ++i) { dm += __builtin_amdgcn_exp2f(s0[i] * 0.5f) + __builtin_amdgcn_exp2f(s1[i] * 0.5f); } asm volatile("" :: "v"(dm)); }
#else
#define ATT_EXTRA_VALU(s0, s1)
#endif
constexpr int LDS_BYTES = 147456 + 64;
constexpr int LDS_BARST = 147456;

__device__ __forceinline__ float bf2f(unsigned short u) { return __uint_as_float(((unsigned)u) << 16); }
__device__ __forceinline__ float bflo(unsigned u) { return __uint_as_float(u << 16); }
__device__ __forceinline__ float bfhi(unsigned u) { return __uint_as_float(u & 0xffff0000u); }
__device__ __forceinline__ unsigned short f2bf(float f) { unsigned u = __float_as_uint(f); return (unsigned short)((u + 0x7fffu + ((u >> 16) & 1u)) >> 16); }
typedef float f32x2_t __attribute__((ext_vector_type(2))); typedef __bf16 bf16x2_t __attribute__((ext_vector_type(2)));
__device__ __forceinline__ unsigned pk2(float lo, float hi) { f32x2_t v = {lo, hi}; bf16x2_t b = __builtin_convertvector(v, bf16x2_t); return __builtin_bit_cast(unsigned, b); }
__device__ __forceinline__ float wave_sum(float v) {
#pragma unroll
    for (int o = 1; o < 64; o <<= 1) v += __shfl_xor(v, o);
    return v;
}
__device__ __forceinline__ float max3f(float a, float b, float c) { float r; asm("v_max3_f32 %0, %1, %2, %3" : "=v"(r) : "v"(a), "v"(b), "v"(c)); return r; }
__device__ __forceinline__ float fadd1(float a, float b, unsigned after) { float r; asm("v_add_f32_e32 %0, %1, %2" : "=v"(r) : "v"(a), "v"(b), "v"(after)); return r; }
__device__ __forceinline__ float fast_sigmoid(float a) { return __builtin_amdgcn_rcpf(1.f + __expf(-a)); }
__device__ __forceinline__ float fast_silu(float a) { return a * fast_sigmoid(a); }
__device__ __forceinline__ float logsigmoid_f(float z) { return fminf(z, 0.f) - __logf(1.f + __expf(-fabsf(z))); }
__device__ __forceinline__ s16x4 vtr(const LAS unsigned char* p) {
    return __builtin_bit_cast(s16x4, __builtin_amdgcn_ds_read_tr16_b64_v4i16((LAS s16x4*)p));
}
__device__ __forceinline__ bf16x8 cat8(s16x4 a, s16x4 b) { return (bf16x8){a[0], a[1], a[2], a[3], b[0], b[1], b[2], b[3]}; }
__device__ __forceinline__ bf16x8 pack8(float a0, float a1, float a2, float a3, float a4, float a5, float a6, float a7) {
    u32x4 w; w.x = pk2(a0, a1); w.y = pk2(a2, a3); w.z = pk2(a4, a5); w.w = pk2(a6, a7);
    return __builtin_bit_cast(bf16x8, w);
}

__device__ __forceinline__ f32x16 zero16() { f32x16 z;
#pragma unroll
    for (int i = 0; i < 16; ++i) z[i] = 0.f;
    asm volatile("" : "+v"(z)); return z; }

struct Params { const float* in[25]; float* out; unsigned char* ws; int ph_lo, ph_hi; };

enum { EPI_SWIGLU = 0, EPI_RESID = 1, EPI_WINA = 2, EPI_WINB = 3, EPI_MERGE1 = 4, EPI_MERGE2 = 5, EPI_RESID_SPLIT = 6 };
constexpr size_t R_PART_OFF = 186;
template <int mode> struct Epi {
    static constexpr bool PERM = true, AFTER_DRAIN = false;
    int gate_i; float gscale; unsigned char* wsp; float* outp; const float* xp; const float* ctxp;
    __device__ __forceinline__ void operator()(const pg8::f32x4 (&acc)[2][2][4][2], const pg8::Unit& u, int wr, int wc, int fr, int fq) const {
        const int rowb = u.pm * 256 + wr * 64 + fr;
        const bool lat = (u.pm * 256) < LROWS;
        const int cin = wc * 32 + 8 * fq;
        unsigned char* const ws = wsp;
        if constexpr (mode == EPI_SWIGLU) {
            bf16_t* const o0 = (bf16_t*)(ws + R_U);
#pragma unroll
            for (int ai = 0; ai < 2; ++ai)
#pragma unroll
                for (int m = 0; m < 4; ++m) {
                    const int row = rowb + ai * 128 + m * 16;
                    const f32x4 a0 = acc[ai][0][m][0], a1 = acc[ai][0][m][1], b0 = acc[ai][1][m][0], b1 = acc[ai][1][m][1];
                    u32x4 w;
                    w.x = pk2(fast_silu(a0[0]) * b0[0], fast_silu(a0[1]) * b0[1]); w.y = pk2(fast_silu(a0[2]) * b0[2], fast_silu(a0[3]) * b0[3]);
                    w.z = pk2(fast_silu(a1[0]) * b1[0], fast_silu(a1[1]) * b1[1]); w.w = pk2(fast_silu(a1[2]) * b1[2], fast_silu(a1[3]) * b1[3]);
                    *(u32x4*)(o0 + (size_t)row * DFF + u.pn * 128 + cin) = w;
                }
        } else if constexpr (mode == EPI_RESID_SPLIT) {
            const float* const mod = (const float*)(ws + CTL_MOD);
            float* const part = (float*)(ws + WS_R + R_PART_OFF * MiB) + (size_t)(u.kb >> 2) * ((size_t)CROWS * DM);
#pragma unroll
            for (int ai = 0; ai < 2; ++ai)
#pragma unroll
                for (int m = 0; m < 4; ++m) {
                    const int row = rowb + ai * 128 + m * 16;
                    const float* gp = mod + (lat ? (row >> 13) : 4) * NMODC + 2 * DM;
#pragma unroll
                    for (int bj = 0; bj < 2; ++bj) {
                        const int col = u.pn * 256 + bj * 128 + cin;
                        const f32x4 g0 = *(const f32x4*)(gp + col), g1 = *(const f32x4*)(gp + col + 4);
                        if (lat) {
                            const f32x4 x0 = *(const f32x4*)(xp + (size_t)row * DM + col), x1 = *(const f32x4*)(xp + (size_t)row * DM + col + 4);
                            *(f32x4*)(outp + (size_t)row * DM + col) = x0 + 0.5f * g0 * acc[ai][bj][m][0];
                            *(f32x4*)(outp + (size_t)row * DM + col + 4) = x1 + 0.5f * g1 * acc[ai][bj][m][1];
                        } else {
                            float* po = part + (size_t)(row - LROWS) * DM + col;
                            *(f32x4*)po = 0.5f * g0 * acc[ai][bj][m][0];
                            *(f32x4*)(po + 4) = 0.5f * g1 * acc[ai][bj][m][1];
                        }
                    }
                }
        } else if constexpr (mode == EPI_RESID) {
            const bool first = (gate_i == 2);
            const float* const xin = first ? xp : outp; const float* const xinc = first ? ctxp : outp;
            float* const of32 = outp; float* const of32c = first ? (float*)(ws + R_XC1) : outp;
            const float* const mod = (const float*)(ws + CTL_MOD);
#pragma unroll
            for (int ai = 0; ai < 2; ++ai)
#pragma unroll
                for (int m = 0; m < 4; ++m) {
                    const int row = rowb + ai * 128 + m * 16;
                    const float* xi = lat ? xin + (size_t)row * DM : xinc + (size_t)(row - LROWS) * DM;
                    float* xo = lat ? of32 + (size_t)row * DM : of32c + (size_t)(row - LROWS) * DM;
                    const float* gp = mod + (lat ? (row >> 13) : 4) * NMODC + gate_i * DM;
#pragma unroll
                    for (int bj = 0; bj < 2; ++bj) {
                        const int col = u.pn * 256 + bj * 128 + cin;
                        const f32x4 g0 = *(const f32x4*)(gp + col), g1 = *(const f32x4*)(gp + col + 4);
                        const f32x4 x0 = *(const f32x4*)(xi + col), x1 = *(const f32x4*)(xi + col + 4);
                        *(f32x4*)(xo + col) = x0 + gscale * g0 * acc[ai][bj][m][0];
                        *(f32x4*)(xo + col + 4) = x1 + gscale * g1 * acc[ai][bj][m][1];
                    }
                }
        } else if constexpr (mode == EPI_WINA) {
            const int pn = u.pn;
            if (pn == 12) {
                float* const of32 = (float*)(ws + R_LR);
                if (wc == 0) {
#pragma unroll
                    for (int ai = 0; ai < 2; ++ai)
#pragma unroll
                        for (int m = 0; m < 4; ++m) {
                            const int row = rowb + ai * 128 + m * 16;
                            *(f32x4*)(of32 + (size_t)row * 32 + 8 * fq) = acc[ai][0][m][0];
                            *(f32x4*)(of32 + (size_t)row * 32 + 8 * fq + 4) = acc[ai][0][m][1];
                        }
                }
                return;
            }
            bf16_t* base; int ld, coff; float sc = 1.f; bool act = false;
            if (pn < 2) { if (!lat) return; base = (bf16_t*)(ws + R_GQ); ld = 512; coff = pn * 256; sc = QSCALE_GLA; }
            else if (pn < 4) { base = (bf16_t*)(ws + R_GK); ld = 512; coff = (pn - 2) * 256; }
            else if (pn < 8) { base = (bf16_t*)(ws + R_GV); ld = 1024; coff = (pn - 4) * 256; }
            else { if (!lat) return; base = (bf16_t*)(ws + WS_GG); ld = 1024; coff = (pn - 8) * 256; act = true; }
#pragma unroll
            for (int ai = 0; ai < 2; ++ai)
#pragma unroll
                for (int m = 0; m < 4; ++m) {
                    const int row = rowb + ai * 128 + m * 16;
#pragma unroll
                    for (int bj = 0; bj < 2; ++bj) {
                        f32x4 v0 = acc[ai][bj][m][0] * sc, v1 = acc[ai][bj][m][1] * sc;
                        if (act) {
#pragma unroll
                            for (int e = 0; e < 4; ++e) { v0[e] = fast_silu(v0[e]); v1[e] = fast_silu(v1[e]); }
                        }
                        u32x4 w; w.x = pk2(v0[0], v0[1]); w.y = pk2(v0[2], v0[3]); w.z = pk2(v1[0], v1[1]); w.w = pk2(v1[2], v1[3]);
                        *(u32x4*)(base + (size_t)row * ld + coff + bj * 128 + cin) = w;
                    }
                }
        } else if constexpr (mode == EPI_WINB) {
            const int pn = u.pn;
            bf16_t* base; int coff; float sc = 1.f; bool act = false, rope_on = false;
            const float* const rope = (const float*)(ws + CTL_ROPE);
            if (pn < 4) { if (!lat) return; base = (bf16_t*)(ws + R_DQ); coff = pn * 256; sc = C2ATT; rope_on = true; }
            else if (pn < 8) { base = (bf16_t*)(ws + R_DK); coff = (pn - 4) * 256; rope_on = lat; }
            else if (pn < 12) { base = (bf16_t*)(ws + R_DV); coff = (pn - 8) * 256; }
            else if (pn < 16) { if (!lat) return; base = (bf16_t*)(ws + R_GA); coff = (pn - 12) * 256; act = true; }
            else { if (!lat) return; base = (bf16_t*)(ws + R_GB); coff = (pn - 16) * 256; act = true; }
#pragma unroll
            for (int ai = 0; ai < 2; ++ai)
#pragma unroll
                for (int m = 0; m < 4; ++m) {
                    const int row = rowb + ai * 128 + m * 16;
#pragma unroll
                    for (int bj = 0; bj < 2; ++bj) {
                        f32x4 v0 = acc[ai][bj][m][0], v1 = acc[ai][bj][m][1];
                        if (rope_on) {
                            const int t = row & (SEQL - 1);
                            const int pos = (wc & 1) ? (t & 63) : (t >> 6);
                            const float* cp = rope + pos * 16 + 8 * (fq & 1);
                            const f32x4 c0 = *(const f32x4*)cp, c1 = *(const f32x4*)(cp + 4);
                            const f32x4 s0 = *(const f32x4*)(cp + 2048), s1 = *(const f32x4*)(cp + 2048 + 4);
                            const float sg = (fq < 2) ? -1.f : 1.f;
                            f32x4 p0, p1;
#pragma unroll
                            for (int e = 0; e < 4; ++e) {
                                auto r0 = __builtin_amdgcn_permlane32_swap(__float_as_uint(v0[e]), __float_as_uint(v0[e]), false, false);
                                auto r1 = __builtin_amdgcn_permlane32_swap(__float_as_uint(v1[e]), __float_as_uint(v1[e]), false, false);
                                p0[e] = __uint_as_float(fq >= 2 ? r0[0] : r0[1]); p1[e] = __uint_as_float(fq >= 2 ? r1[0] : r1[1]);
                            }
                            v0 = v0 * c0 + sg * p0 * s0; v1 = v1 * c1 + sg * p1 * s1;
                        }
                        v0 = v0 * sc; v1 = v1 * sc;
                        if (act) {
#pragma unroll
                            for (int e = 0; e < 4; ++e) { v0[e] = fast_sigmoid(v0[e]); v1[e] = fast_sigmoid(v1[e]); }
                        }
                        u32x4 w; w.x = pk2(v0[0], v0[1]); w.y = pk2(v0[2], v0[3]); w.z = pk2(v1[0], v1[1]); w.w = pk2(v1[2], v1[3]);
                        *(u32x4*)(base + (size_t)row * DM + coff + bj * 128 + cin) = w;
                    }
                }
        } else {
            bf16_t* const o0 = (bf16_t*)(ws + R_GA); const bf16_t* const o1 = (const bf16_t*)(ws + R_GB);
#pragma unroll
            for (int ai = 0; ai < 2; ++ai)
#pragma unroll
                for (int m = 0; m < 4; ++m) {
                    const int row = rowb + ai * 128 + m * 16;
#pragma unroll
                    for (int bj = 0; bj < 2; ++bj) {
                        const size_t off = (size_t)row * DM + u.pn * 256 + bj * 128 + cin;
                        const u32x4 ga = *(const u32x4*)(o0 + off);
                        const f32x4 v0 = acc[ai][bj][m][0], v1 = acc[ai][bj][m][1];
                        float r[8];
                        if constexpr (mode == EPI_MERGE1) {
                            r[0] = bflo(ga.x) * v0[0]; r[1] = bfhi(ga.x) * v0[1]; r[2] = bflo(ga.y) * v0[2]; r[3] = bfhi(ga.y) * v0[3];
                            r[4] = bflo(ga.z) * v1[0]; r[5] = bfhi(ga.z) * v1[1]; r[6] = bflo(ga.w) * v1[2]; r[7] = bfhi(ga.w) * v1[3];
                        } else {
                            const u32x4 gb = *(const u32x4*)(o1 + off);
                            r[0] = bflo(ga.x) + bflo(gb.x) * v0[0]; r[1] = bfhi(ga.x) + bfhi(gb.x) * v0[1]; r[2] = bflo(ga.y) + bflo(gb.y) * v0[2]; r[3] = bfhi(ga.y) + bfhi(gb.y) * v0[3];
                            r[4] = bflo(ga.z) + bflo(gb.z) * v1[0]; r[5] = bfhi(ga.z) + bfhi(gb.z) * v1[1]; r[6] = bflo(ga.w) + bflo(gb.w) * v1[2]; r[7] = bfhi(ga.w) + bfhi(gb.w) * v1[3];
                        }
                        u32x4 w; w.x = pk2(r[0], r[1]); w.y = pk2(r[2], r[3]); w.z = pk2(r[4], r[5]); w.w = pk2(r[6], r[7]);
                        *(u32x4*)(o0 + off) = w;
                    }
                }
        }
    }
};

__device__ __forceinline__ void transpose_item(const float* W, int ldw, int src_n0, bf16_t* WT, int K, int dst_r0, int k0, LAS float* scr, int lane) {
    if (src_n0 >= 0) {
#pragma unroll 8
        for (int i = 0; i < 32; ++i) { const int kk = 2 * i + (lane >> 5); scr[kk * 33 + (lane & 31)] = W[(size_t)(k0 + kk) * ldw + src_n0 + (lane & 31)]; }
    } else {
#pragma unroll 8
        for (int i = 0; i < 32; ++i) { const int kk = 2 * i + (lane >> 5); scr[kk * 33 + (lane & 31)] = 0.f; }
    }
    asm volatile("s_waitcnt lgkmcnt(0)" ::: "memory");
    const int c = lane & 7;
#pragma unroll
    for (int j = 0; j < 4; ++j) {
        const int n = (lane >> 3) + 8 * j; const LAS float* s = scr + (8 * c) * 33 + n;
        u32x4 o; o.x = pk2(s[0 * 33], s[1 * 33]); o.y = pk2(s[2 * 33], s[3 * 33]); o.z = pk2(s[4 * 33], s[5 * 33]); o.w = pk2(s[6 * 33], s[7 * 33]);
        *(u32x4*)(WT + (size_t)(dst_r0 + n) * K + k0 + 8 * c) = o;
    }
    asm volatile("s_waitcnt lgkmcnt(0)" ::: "memory");
}

__device__ __forceinline__ void phase_prep(const Params& p, LAS unsigned char* lds) {
    const int tid = threadIdx.x, lane = tid & 63, wave = tid >> 6;
    unsigned char* ws = p.ws;
    {
        LAS float* sc = (LAS float*)lds;
        LAS float* red = (LAS float*)(lds + 20480);
        for (int i = tid; i < 5 * DM; i += 512) { const int v = i >> 10, k = i & 1023; const float cv = (v < 4) ? p.in[1][v * DM + k] : p.in[3][k]; sc[i] = fast_silu(cv); }
        __syncthreads();
        float* MOD = (float*)(ws + CTL_MOD);
        for (int it = blockIdx.x; it < 72; it += gridDim.x) {
            const int col = tid & 127, kq = tid >> 7, j = it * 128 + col, kb = kq * 256;
            float a0 = 0.f, a1 = 0.f, a2 = 0.f, a3 = 0.f, a4 = 0.f;
#pragma unroll 32
            for (int k = 0; k < 256; ++k) {
                const float w = p.in[4][(size_t)(kb + k) * NMODC + j];
                a0 += sc[kb + k] * w; a1 += sc[DM + kb + k] * w; a2 += sc[2 * DM + kb + k] * w; a3 += sc[3 * DM + kb + k] * w; a4 += sc[4 * DM + kb + k] * w;
            }
            red[(kq * 5 + 0) * 128 + col] = a0; red[(kq * 5 + 1) * 128 + col] = a1; red[(kq * 5 + 2) * 128 + col] = a2; red[(kq * 5 + 3) * 128 + col] = a3; red[(kq * 5 + 4) * 128 + col] = a4;
            __syncthreads();
            for (int o = tid; o < 640; o += 512) {
                const int v = o >> 7, c = o & 127;
                MOD[v * NMODC + it * 128 + c] = p.in[5][it * 128 + c] + ((red[(0 * 5 + v) * 128 + c] + red[(1 * 5 + v) * 128 + c]) + (red[(2 * 5 + v) * 128 + c] + red[(3 * 5 + v) * 128 + c]));
            }
            __syncthreads();
        }
        __syncthreads();
    }
    if (blockIdx.x == 0) {
        float* rope = (float*)(ws + CTL_ROPE);
        for (int i = tid; i < 2048; i += 512) {
            const int pos = i >> 4, q = i & 15;
            const float inv = powf(10000.f, -(float)q / 16.f);
            const float ang = (float)pos * inv;
            rope[i] = cosf(ang); rope[2048 + i] = sinf(ang);
        }
    }
    if (blockIdx.x == (gridDim.x > 1 ? 1 : 0) && tid == 0) {
        const float* dl = p.in[15];
        float s1 = 0.f, s2 = 0.f;
        for (int i = 0; i < 64; ++i) { s1 += dl[i] * dl[64 + i]; s2 += dl[128 + i] * dl[192 + i]; }
        *(float*)(ws + CTL_LAM) = expf(s1) - expf(s2) + LAM_INIT;
    }
}

__device__ __forceinline__ void phase_wcopy(const Params& p, LAS unsigned char* lds) {
    const int tid = threadIdx.x, lane = tid & 63, wave = tid >> 6;
    unsigned char* ws = p.ws;
    LAS float* scr = (LAS float*)(lds + 32768 + wave * 8448);
    const int gw = blockIdx.x * 8 + wave, NGW = gridDim.x * 8;
    constexpr int I_13 = 176 * 16, I_2 = 32 * 44, I_WA = 104 * 16, I_WB = 160 * 16, I_SQ = 32 * 16;
    constexpr int NITEMS = 2 * I_13 + 2 * I_2 + I_WA + I_WB + 3 * I_SQ;
    for (int it = gw; it < NITEMS; it += NGW) {
        int r = it;
        if (r < 2 * I_13) {
            const int second = r >= I_13; if (second) r -= I_13;
            const int rb = r / 16, kb = r % 16, pn = rb >> 3, jb = rb & 7;
            const float* src = (jb < 4) ? p.in[second ? 21 : 7] : p.in[second ? 22 : 8];
            transpose_item(src, DFF, pn * 128 + (jb & 3) * 32, (bf16_t*)(ws + (second ? W_W13B : W_W13A)), DM, rb * 32, kb * 64, scr, lane);
            continue;
        }
        r -= 2 * I_13;
        if (r < 2 * I_2) {
            const int second = r >= I_2; if (second) r -= I_2;
            const int rb = r / 44, kb = r % 44;
            transpose_item(p.in[second ? 23 : 9], DM, rb * 32, (bf16_t*)(ws + (second ? W_W2B : W_W2A)), DFF, rb * 32, kb * 64, scr, lane);
            continue;
        }
        r -= 2 * I_2;
        if (r < I_WA) {
            const int rb = r / 16, kb = r % 16;
            transpose_item(p.in[11], 8224, rb < 97 ? rb * 32 : -1, (bf16_t*)(ws + W_WINA), DM, rb * 32, kb * 64, scr, lane);
            continue;
        }
        r -= I_WA;
        if (r < I_WB) {
            const int rb = r / 16, kb = r % 16;
            transpose_item(p.in[11], 8224, 3104 + rb * 32, (bf16_t*)(ws + W_WINB), DM, rb * 32, kb * 64, scr, lane);
            continue;
        }
        r -= I_WB;
        {
            const int which = r / I_SQ; r -= which * I_SQ;
            const int rb = r / 16, kb = r % 16;
            transpose_item(p.in[17 + which], DM, rb * 32, (bf16_t*)(ws + (which == 0 ? W_WBG : which == 1 ? W_WBD : W_WOUT)), DM, rb * 32, kb * 64, scr, lane);
        }
    }
}

__device__ __forceinline__ void phase_modnorm(const float* lat, const float* ctxp, int nrows, const float* normw, const float* mod, int shift_i, int scale_i, bf16_t* H, const float* part = nullptr) {
    const int lane = threadIdx.x & 63, wave = threadIdx.x >> 6;
    const int gw = blockIdx.x * 8 + wave, NGW = gridDim.x * 8;
    for (int row = gw; row < nrows; row += NGW) {
        const bool isl = row < LROWS;
        const float* src = isl ? lat + (size_t)row * DM : ctxp + (size_t)(row - LROWS) * DM;
        const float* mp = mod + (isl ? (row >> 13) : 4) * NMODC;
        f32x4 v[4]; float ss = 0.f;
#pragma unroll
        for (int j = 0; j < 4; ++j) {
            v[j] = *(const f32x4*)(src + 256 * j + 4 * lane);
            if (part != nullptr && !isl) {
#pragma unroll
                for (int sk = 0; sk < 11; ++sk) v[j] += *(const f32x4*)(part + (size_t)sk * ((size_t)CROWS * DM) + (size_t)(row - LROWS) * DM + 256 * j + 4 * lane);
            }
            ss += (v[j].x * v[j].x + v[j].y * v[j].y) + (v[j].z * v[j].z + v[j].w * v[j].w); }
        const float r = rsqrtf(wave_sum(ss) * (1.f / DM) + EPSN);
#pragma unroll
        for (int j = 0; j < 4; ++j) {
            const int c = 256 * j + 4 * lane;
            const f32x4 g = *(const f32x4*)(normw + c), sc = *(const f32x4*)(mp + scale_i * DM + c), sh = *(const f32x4*)(mp + shift_i * DM + c);
            const f32x4 y = (v[j] * r * g) * (1.f + sc) + sh;
            u32x2 w; w.x = pk2(y.x, y.y); w.y = pk2(y.z, y.w);
            *(u32x2*)(H + (size_t)row * DM + c) = w;
        }
    }
}
__device__ __forceinline__ void phase_finalnorm(float* xo, const float* normw) {
    const int lane = threadIdx.x & 63, wave = threadIdx.x >> 6;
    const int gw = blockIdx.x * 8 + wave, NGW = gridDim.x * 8;
    for (int row = gw; row < LROWS; row += NGW) {
        float* src = xo + (size_t)row * DM;
        f32x4 v[4]; float ss = 0.f;
#pragma unroll
        for (int j = 0; j < 4; ++j) { v[j] = *(const f32x4*)(src + 256 * j + 4 * lane); ss += (v[j].x * v[j].x + v[j].y * v[j].y) + (v[j].z * v[j].z + v[j].w * v[j].w); }
        const float r = rsqrtf(wave_sum(ss) * (1.f / DM) + EPSN);
#pragma unroll
        for (int j = 0; j < 4; ++j) { const int c = 256 * j + 4 * lane; const f32x4 g = *(const f32x4*)(normw + c); *(f32x4*)(src + c) = v[j] * r * g; }
    }
}

__device__ __forceinline__ int gla_row(int b, int cid, int t) { return cid < 4 ? LROWS + b * NCTX + cid * 64 + t : b * SEQL + (cid - 4) * 64 + t; }
__device__ __forceinline__ bf16x8 tr_frag(const LAS unsigned char* tile, int stride, int k0, int c0, int lane) {
    const int h = lane >> 5, q = (lane & 15) >> 2, pp = lane & 3, g1 = (lane >> 4) & 1;
    const LAS unsigned char* a = tile + (k0 + 8 * h + q) * stride + (c0 + 16 * g1 + 4 * pp) * 2;
    return cat8(vtr(a), vtr(a + 4 * stride));
}
__device__ __forceinline__ bf16x8 tr_frag_perm(const LAS unsigned char* tile, int stride, int k0, int c0, int lane) {
    const int h = lane >> 5, q = (lane & 15) >> 2, pp = lane & 3, g1 = (lane >> 4) & 1;
    const LAS unsigned char* a = tile + (k0 + 4 * h + q) * stride + (c0 + 16 * g1 + 4 * pp) * 2;
    return cat8(vtr(a), vtr(a + 8 * stride));
}
__device__ __forceinline__ bf16x8 row_frag(const LAS unsigned char* tile, int stride, int r0, int k0, int lane) {
    return *(const LAS bf16x8*)(tile + (r0 + (lane & 31)) * stride + (k0 + 8 * (lane >> 5)) * 2);
}

constexpr int VT_STRIDE = 576, KH_STRIDE = 320, QK_STRIDE = 272, AM_STRIDE = 144, OB_STRIDE = 1040;

__device__ __forceinline__ void gla_stage(const unsigned char* ws, int b, int h, int cid, LAS float* lrs, LAS unsigned char* vt, LAS unsigned char* rawk, LAS unsigned char* rawq) {
    const int tid = threadIdx.x;
    const float* LR = (const float*)(ws + R_LR); const bf16_t* GV = (const bf16_t*)(ws + R_GV);
    const bf16_t* GK = (const bf16_t*)(ws + R_GK); const bf16_t* GQ = (const bf16_t*)(ws + R_GQ);
    { const int t = tid >> 3, c = (tid & 7) * 4; *(LAS f32x4*)(lrs + t * 32 + c) = *(const f32x4*)(LR + (size_t)gla_row(b, cid, t) * 32 + c); }
#pragma unroll
    for (int i = 0; i < 4; ++i) {
        const int idx = tid + 512 * i, t = idx >> 5, ch = idx & 31;
        *(LAS u32x4*)(vt + t * VT_STRIDE + ch * 16) = *(const u32x4*)(GV + (size_t)gla_row(b, cid, t) * DM + h * 256 + ch * 8);
    }
#pragma unroll
    for (int i = 0; i < 2; ++i) {
        const int idx = tid + 512 * i, t = idx >> 4, ch = idx & 15;
        const size_t g = (size_t)gla_row(b, cid, t) * 512 + h * 128 + ch * 8;
        *(LAS u32x4*)(rawk + t * 256 + ch * 16) = *(const u32x4*)(GK + g);
        if (rawq) *(LAS u32x4*)(rawq + t * 256 + ch * 16) = *(const u32x4*)(GQ + g);
    }
}

__device__ __forceinline__ void gla_gates(const LAS float* lrs, const float* W2, const float* bias, int h, int dir, int dblk, int lane, float (&L)[2][16], float (&P)[2][16], float& total) {
    const int r32 = lane & 31, hh = lane >> 5, d = 32 * dblk + r32;
    float wv[8];
#pragma unroll
    for (int j = 0; j < 8; ++j) wv[j] = W2[(size_t)(dir * 16 + 8 * hh + j) * 512 + h * 128 + d];
    u32x4 wh, wl;
    wh.x = pk2(wv[0], wv[1]); wh.y = pk2(wv[2], wv[3]); wh.z = pk2(wv[4], wv[5]); wh.w = pk2(wv[6], wv[7]);
    wl.x = pk2(wv[0] - bflo(wh.x), wv[1] - bfhi(wh.x)); wl.y = pk2(wv[2] - bflo(wh.y), wv[3] - bfhi(wh.y));
    wl.z = pk2(wv[4] - bflo(wh.z), wv[5] - bfhi(wh.z)); wl.w = pk2(wv[6] - bflo(wh.w), wv[7] - bfhi(wh.w));
    const bf16x8 whi = __builtin_bit_cast(bf16x8, wh), wlo = __builtin_bit_cast(bf16x8, wl);
    const float bs = bias[dir * 512 + h * 128 + d];
#pragma unroll
    for (int th = 0; th < 2; ++th) {
        const LAS float* ap = lrs + (32 * th + r32) * 32 + dir * 16 + 8 * hh;
        const f32x4 a0 = *(const LAS f32x4*)ap, a1 = *(const LAS f32x4*)(ap + 4);
        u32x4 ah, al;
        ah.x = pk2(a0.x, a0.y); ah.y = pk2(a0.z, a0.w); ah.z = pk2(a1.x, a1.y); ah.w = pk2(a1.z, a1.w);
        al.x = pk2(a0.x - bflo(ah.x), a0.y - bfhi(ah.x)); al.y = pk2(a0.z - bflo(ah.y), a0.w - bfhi(ah.y));
        al.z = pk2(a1.x - bflo(ah.z), a1.y - bfhi(ah.z)); al.w = pk2(a1.z - bflo(ah.w), a1.w - bfhi(ah.w));
        const bf16x8 ahi = __builtin_bit_cast(bf16x8, ah), alo = __builtin_bit_cast(bf16x8, al);
        f32x16 z;
#pragma unroll
        for (int i = 0; i < 16; ++i) z[i] = bs;
        z = __builtin_amdgcn_mfma_f32_32x32x16_bf16(ahi, whi, z, 0, 0, 0);
        z = __builtin_amdgcn_mfma_f32_32x32x16_bf16(alo, whi, z, 0, 0, 0);
        z = __builtin_amdgcn_mfma_f32_32x32x16_bf16(ahi, wlo, z, 0, 0, 0);
#pragma unroll
        for (int i = 0; i < 16; ++i) L[th][i] = logsigmoid_f(z[i]) * (1.f / 16.f);
    }
    float base = 0.f;
#pragma unroll
    for (int th = 0; th < 2; ++th)
#pragma unroll
        for (int g = 0; g < 4; ++g) {
            const float p0 = L[th][4 * g], p1 = p0 + L[th][4 * g + 1], p2 = p1 + L[th][4 * g + 2], p3 = p2 + L[th][4 * g + 3];
            auto rr = __builtin_amdgcn_permlane32_swap(__float_as_uint(p3), __float_as_uint(p3), false, false);
            const float gp = __uint_as_float(hh ? rr[0] : rr[1]);
            const float off = hh ? base + gp : base;
            P[th][4 * g] = off + p0; P[th][4 * g + 1] = off + p1; P[th][4 * g + 2] = off + p2; P[th][4 * g + 3] = off + p3;
            base += p3 + gp;
        }
    total = base;
}

__device__ __forceinline__ void phase_gla_a(const Params& p, LAS unsigned char* lds, int half) {
    const int tid = threadIdx.x, lane = tid & 63, wave = tid >> 6;
    unsigned char* ws = p.ws;
    LAS float* lrs = (LAS float*)lds;
    LAS unsigned char* vt = lds + 8192;
    LAS unsigned char* kh = lds + 8192 + 36864;
    LAS unsigned char* rawk = lds + 8192 + 36864 + 40960;
    const bf16_t* GK = (const bf16_t*)(ws + R_GK);
    float* DEC = (float*)(ws + R_DEC);
    bf16_t* Sb = (bf16_t*)(ws + R_S);
    for (int it = blockIdx.x; it < 2 * 4 * NCH; it += gridDim.x) {
        const int bl = it / (4 * NCH), h = (it / NCH) & 3, cid = it % NCH, b = half * 2 + bl;
        gla_stage(ws, b, h, cid, lrs, vt, rawk, nullptr);
        __syncthreads();
        {
            const int dir = wave >> 2, dblk = wave & 3, d = 32 * dblk + (lane & 31), hh = lane >> 5;
            float L[2][16], P[2][16], total;
            gla_gates(lrs, p.in[12], p.in[13], h, dir, dblk, lane, L, P, total);
            LAS unsigned char* khd = kh + dir * (64 * KH_STRIDE);
#pragma unroll
            for (int th = 0; th < 2; ++th)
#pragma unroll
                for (int i = 0; i < 16; ++i) {
                    const int t = 32 * th + 8 * (i >> 2) + 4 * hh + (i & 3);
                    const float e = dir == 0 ? total - P[th][i] : P[th][i] - L[th][i];
                    const float kv = bf2f(*(const LAS unsigned short*)(rawk + t * 256 + d * 2));
                    *(LAS unsigned short*)(khd + t * KH_STRIDE + d * 2) = f2bf(kv * __expf(e));
                }
            if (hh == 0) DEC[((size_t)it * 2 + dir) * 128 + d] = __expf(total);
        }
        __syncthreads();
#pragma unroll 1
        for (int dir = 0; dir < 2; ++dir) {
            const LAS unsigned char* khd = kh + dir * (64 * KH_STRIDE);
            f32x16 acc[4];
#pragma unroll
            for (int mb = 0; mb < 4; ++mb) acc[mb] = zero16();
#pragma unroll
            for (int ks = 0; ks < 4; ++ks) {
                const bf16x8 bfr = tr_frag(vt, VT_STRIDE, 16 * ks, 32 * wave, lane);
#pragma unroll
                for (int mb = 0; mb < 4; ++mb) {
                    const bf16x8 afr = tr_frag(khd, KH_STRIDE, 16 * ks, 32 * mb, lane);
                    acc[mb] = __builtin_amdgcn_mfma_f32_32x32x16_bf16(afr, bfr, acc[mb], 0, 0, 0);
                }
            }
            bf16_t* So = Sb + ((size_t)(((bl * 2 + dir) * 4 + h) * NCH + cid)) * 32768 + (size_t)wave * 4096 + (lane & 31) * 8 + 4 * (lane >> 5);
#pragma unroll
            for (int mb = 0; mb < 4; ++mb)
#pragma unroll
                for (int g = 0; g < 4; ++g) {
                    u32x2 w; w.x = pk2(acc[mb][4 * g], acc[mb][4 * g + 1]); w.y = pk2(acc[mb][4 * g + 2], acc[mb][4 * g + 3]);
                    *(u32x2*)(So + ((2 * mb + (g >> 1)) * 2 + (g & 1)) * 256) = w;
                }
        }
        __syncthreads();
    }
}

__device__ __forceinline__ void phase_gla_scan(const Params& p) {
    const int tid = threadIdx.x;
    unsigned char* ws = p.ws;
    const float* DEC = (const float*)(ws + R_DEC);
    bf16_t* Sb = (bf16_t*)(ws + R_S);
    for (int it = blockIdx.x; it < 256; it += gridDim.x) {
        const int seq = it >> 4, part = it & 15;
        const int bl = seq >> 3, dir = (seq >> 2) & 1, h = seq & 3;
        const int eo = part * 2048 + tid * 4, d = 16 * ((eo >> 9) & 7) + 8 * ((eo >> 8) & 1) + (eo & 7);
        float S0 = 0.f, S1 = 0.f, S2 = 0.f, S3 = 0.f;
        bf16_t* sbase = Sb + (size_t)(((bl * 2 + dir) * 4 + h) * NCH) * 32768 + eo;
        const float* dbase = DEC + ((size_t)((bl * 4 + h) * NCH) * 2 + dir) * 128 + d;
        u32x2 dvA[6]; f32x4 dcA[6];
#pragma unroll
        for (int j = 0; j < 6; ++j) {
            const int cid = dir == 0 ? j : (j < 4 ? 3 - j : 135 - j);
            dvA[j] = *(const u32x2*)(sbase + (size_t)cid * 32768); dcA[j] = *(const f32x4*)(dbase + (size_t)cid * 256);
        }
#pragma unroll 1
        for (int st = 0; st < NCH; st += 6) {
            u32x2 dvB[6]; f32x4 dcB[6];
            const int sn = st + 6 < NCH ? st + 6 : st;
#pragma unroll
            for (int j = 0; j < 6; ++j) {
                const int s2 = sn + j, cid = dir == 0 ? s2 : (s2 < 4 ? 3 - s2 : 135 - s2);
                dvB[j] = *(const u32x2*)(sbase + (size_t)cid * 32768); dcB[j] = *(const f32x4*)(dbase + (size_t)cid * 256);
            }
#pragma unroll
            for (int j = 0; j < 6; ++j) {
                const int s2 = st + j, cid = dir == 0 ? s2 : (s2 < 4 ? 3 - s2 : 135 - s2);
                u32x2 w; w.x = pk2(S0, S1); w.y = pk2(S2, S3);
                *(u32x2*)(sbase + (size_t)cid * 32768) = w;
                S0 = dcA[j].x * S0 + bflo(dvA[j].x); S1 = dcA[j].y * S1 + bfhi(dvA[j].x); S2 = dcA[j].z * S2 + bflo(dvA[j].y); S3 = dcA[j].w * S3 + bfhi(dvA[j].y);
            }
#pragma unroll
            for (int j = 0; j < 6; ++j) { dvA[j] = dvB[j]; dcA[j] = dcB[j]; }
        }
    }
}

__device__ __forceinline__ void phase_gla_c(const Params& p, LAS unsigned char* lds, int half, bool to_scratch = false) {
    const int tid = threadIdx.x, lane = tid & 63, wave = tid >> 6;
    unsigned char* ws = p.ws;
    LAS unsigned char* qk = lds;
    LAS unsigned char* vt = lds + 69632;
    LAS float* lrs = (LAS float*)(lds + 69632 + 36864);
    LAS unsigned char* rawk = lds + 69632 + 36864 + 8192;
    LAS unsigned char* rawq = lds + 69632 + 36864 + 8192 + 16384;
    LAS unsigned char* am = rawq;
    static_assert(69632 + 36864 + 8192 + 16384 + 16384 <= LDS_BYTES, "GLA (c) LDS");
    const bf16_t* GQ = (const bf16_t*)(ws + R_GQ); const bf16_t* GK = (const bf16_t*)(ws + R_GK);
    const bf16_t* Sb = (const bf16_t*)(ws + R_S);
    bf16_t* GG = (bf16_t*)(ws + WS_GG);
    for (int it = blockIdx.x; it < 2 * 4 * 128; it += gridDim.x) {
        const int bl = it >> 9, h = (it >> 7) & 3, lc = it & 127, cid = lc + 4, b = half * 2 + bl;
        bf16x8 sfr[2][8];
#pragma unroll
        for (int dir = 0; dir < 2; ++dir) {
            const bf16_t* Sp = Sb + ((size_t)(((bl * 2 + dir) * 4 + h) * NCH + cid)) * 32768 + (size_t)wave * 4096 + (lane >> 5) * 256 + (lane & 31) * 8;
#pragma unroll
            for (int ks = 0; ks < 8; ++ks) sfr[dir][ks] = *(const bf16x8*)(Sp + 512 * ks);
        }
        gla_stage(ws, b, h, cid, lrs, vt, rawk, rawq);
        __syncthreads();
        {
            const int dir = wave >> 2, dblk = wave & 3, d = 32 * dblk + (lane & 31), hh = lane >> 5;
            float L[2][16], P[2][16], total;
            gla_gates(lrs, p.in[12], p.in[13], h, dir, dblk, lane, L, P, total);
            LAS unsigned char* qd = qk + (dir * 2) * (64 * QK_STRIDE);
            LAS unsigned char* kd = qk + (dir * 2 + 1) * (64 * QK_STRIDE);
#pragma unroll
            for (int th = 0; th < 2; ++th)
#pragma unroll
                for (int i = 0; i < 16; ++i) {
                    const int t = 32 * th + 8 * (i >> 2) + 4 * hh + (i & 3);
                    const float e = dir == 0 ? P[th][i] : total - P[th][i] + L[th][i];
                    const float qv = bf2f(*(const LAS unsigned short*)(rawq + t * 256 + d * 2));
                    const float kv = bf2f(*(const LAS unsigned short*)(rawk + t * 256 + d * 2));
                    *(LAS unsigned short*)(qd + t * QK_STRIDE + d * 2) = f2bf(qv * __expf(e));
                    *(LAS unsigned short*)(kd + t * QK_STRIDE + d * 2) = f2bf(kv * __expf(-e));
                }
        }
        __syncthreads();
        if (wave < 4) {
            const int th = wave >> 1, sh = wave & 1;
            f32x16 cf = zero16(), cb = zero16();
#pragma unroll
            for (int ks = 0; ks < 8; ++ks) {
                const bf16x8 aqf = row_frag(qk, QK_STRIDE, 32 * th, 16 * ks, lane);
                const bf16x8 bkf = row_frag(qk + 1 * (64 * QK_STRIDE), QK_STRIDE, 32 * sh, 16 * ks, lane);
                cf = __builtin_amdgcn_mfma_f32_32x32x16_bf16(aqf, bkf, cf, 0, 0, 0);
                const bf16x8 aqb = row_frag(qk + 2 * (64 * QK_STRIDE), QK_STRIDE, 32 * th, 16 * ks, lane);
                const bf16x8 bkb = row_frag(qk + 3 * (64 * QK_STRIDE), QK_STRIDE, 32 * sh, 16 * ks, lane);
                cb = __builtin_amdgcn_mfma_f32_32x32x16_bf16(aqb, bkb, cb, 0, 0, 0);
            }
            const int sg = 32 * sh + (lane & 31);
#pragma unroll
            for (int i = 0; i < 16; ++i) {
                const int tg = 32 * th + 8 * (i >> 2) + 4 * (lane >> 5) + (i & 3);
                const float v = (sg <= tg ? cf[i] : 0.f) + (sg >= tg ? cb[i] : 0.f);
                const unsigned hv = f2bf(v), ov = __shfl_xor(hv, 1);
                if (!(lane & 1)) *(LAS unsigned*)(am + tg * AM_STRIDE + sg * 2) = hv | (ov << 16);
            }
        }
        f32x16 oacc[2]; oacc[0] = zero16(); oacc[1] = zero16();
#pragma unroll
        for (int dir = 0; dir < 2; ++dir)
#pragma unroll
            for (int ks = 0; ks < 8; ++ks)
#pragma unroll
                for (int th = 0; th < 2; ++th) {
                    const bf16x8 a = row_frag(qk + (dir * 2) * (64 * QK_STRIDE), QK_STRIDE, 32 * th, 16 * ks, lane);
                    oacc[th] = __builtin_amdgcn_mfma_f32_32x32x16_bf16(a, sfr[dir][ks], oacc[th], 0, 0, 0);
                }
        __syncthreads();
#pragma unroll
        for (int ks = 0; ks < 4; ++ks) {
            const bf16x8 bfr = tr_frag(vt, VT_STRIDE, 16 * ks, 32 * wave, lane);
#pragma unroll
            for (int th = 0; th < 2; ++th) {
                const bf16x8 a = row_frag(am, AM_STRIDE, 32 * th, 16 * ks, lane);
                oacc[th] = __builtin_amdgcn_mfma_f32_32x32x16_bf16(a, bfr, oacc[th], 0, 0, 0);
            }
        }
        __syncthreads();
#pragma unroll
        for (int th = 0; th < 2; ++th)
#pragma unroll
            for (int i = 0; i < 16; ++i) {
                const int tg = 32 * th + 8 * (i >> 2) + 4 * (lane >> 5) + (i & 3);
                *(LAS float*)(qk + tg * OB_STRIDE + (32 * wave + (lane & 31)) * 4) = oacc[th][i];
            }
        __syncthreads();
        {
            u32x2 gt[8]; f32x4 ov[8]; float ssv[8];
            const f32x4 g = *(const f32x4*)(p.in[14] + h * 256 + 4 * lane);
#pragma unroll
            for (int rr = 0; rr < 8; ++rr) {
                const int t = wave * 8 + rr;
                gt[rr] = *(const u32x2*)(GG + (size_t)gla_row(b, cid, t) * DM + h * 256 + 4 * lane);
                ov[rr] = *(const LAS f32x4*)(qk + t * OB_STRIDE + lane * 16);
                ssv[rr] = (ov[rr].x * ov[rr].x + ov[rr].y * ov[rr].y) + (ov[rr].z * ov[rr].z + ov[rr].w * ov[rr].w);
            }
#pragma unroll
            for (int o = 1; o < 64; o <<= 1)
#pragma unroll
                for (int rr = 0; rr < 8; ++rr) ssv[rr] += __shfl_xor(ssv[rr], o);
#pragma unroll
            for (int rr = 0; rr < 8; ++rr) {
                const int t = wave * 8 + rr;
                const float r = rsqrtf(ssv[rr] * (1.f / 256.f) + EPSN);
                u32x2 w; w.x = pk2(ov[rr].x * r * g.x * bflo(gt[rr].x), ov[rr].y * r * g.y * bfhi(gt[rr].x)); w.y = pk2(ov[rr].z * r * g.z * bflo(gt[rr].y), ov[rr].w * r * g.w * bfhi(gt[rr].y));
                *(u32x2*)((to_scratch ? (bf16_t*)(ws + R_GA) : GG) + (size_t)gla_row(b, cid, t) * DM + h * 256 + 4 * lane) = w;
            }
        }
        __syncthreads();
    }
}

constexpr int AQ_STRIDE = 272, ATILE = 64 * 256;
__device__ __forceinline__ int att_krow(int b, int tile, int r) { return tile < 4 ? LROWS + b * NCTX + tile * 64 + r : b * SEQL + (tile - 4) * 64 + r; }
__device__ __forceinline__ void att_dma_tile(const bf16_t* DK, const bf16_t* DV, int b, int hd, int tile, LAS unsigned char* kdst, LAS unsigned char* vdst, int wave_u, int lane) {
#pragma unroll
    for (int i = 0; i < 2; ++i) {
        const int j = wave_u + 8 * i;
        const int row = 4 * j + (lane >> 4), pc = lane & 15;
        const size_t g = (size_t)att_krow(b, tile, row) * DM + hd * 128;
        __builtin_amdgcn_global_load_lds((const unsigned*)(DK + g + ((pc ^ (row & 15)) << 3)), (LAS unsigned*)(kdst + j * 1024), 16, 0, 0);
        __builtin_amdgcn_global_load_lds((const unsigned*)(DV + g + ((pc ^ ((row & 3) << 2)) << 3)), (LAS unsigned*)(vdst + j * 1024), 16, 0, 0);
    }
}

template <bool SAFE>
__device__ __forceinline__ bool att_unit(const Params& p, LAS unsigned char* lds, int b, int hd, int qb) {
    const int tid = threadIdx.x, lane = tid & 63, wave = __builtin_amdgcn_readfirstlane(tid >> 6), r32 = lane & 31, hi = lane >> 5;
    unsigned char* ws = p.ws;
    const bf16_t* DQ = (const bf16_t*)(ws + R_DQ); const bf16_t* DK = (const bf16_t*)(ws + R_DK); const bf16_t* DV = (const bf16_t*)(ws + R_DV);
    const float lam = *(const float*)(ws + CTL_LAM);
    LAS unsigned char* kbuf = lds;
    LAS unsigned char* vbuf = lds + 2 * ATILE;
    LAS unsigned char* qbuf = lds + 4 * ATILE;
    static_assert(4 * ATILE + 8 * 32 * AQ_STRIDE + 2048 <= LDS_BARST, "attention LDS");
        const int qrow = b * SEQL + qb * 256 + wave * 32 + r32;
        {
            int l0 = lane; asm volatile("" : "+v"(l0));
            LAS unsigned char* qw = qbuf + wave * (32 * AQ_STRIDE);
#pragma unroll
            for (int i = 0; i < 8; ++i) {
                const int idx = l0 + 64 * i, row = idx >> 4, ch = idx & 15;
                *(LAS u32x4*)(qw + row * AQ_STRIDE + ch * 16) = *(const u32x4*)(DQ + (size_t)(b * SEQL + qb * 256 + wave * 32 + row) * DM + hd * 128 + ch * 8);
            }
            asm volatile("" ::: "memory");
            att_dma_tile(DK, DV, b, hd, 0, kbuf, vbuf, wave, l0);
            asm volatile("" ::: "memory");
        }
        f32x16 O[2][4];
#pragma unroll
        for (int c = 0; c < 2; ++c)
#pragma unroll
            for (int j = 0; j < 4; ++j) O[c][j] = zero16();
        float mrun[2] = {-1e30f, -1e30f}, lrun[2] = {0.f, 0.f};
        asm volatile("s_waitcnt vmcnt(0)" ::: "memory");
        __syncthreads();
        if constexpr (!SAFE) { if (tid == 0) *(volatile LAS unsigned*)(lds + LDS_BARST + 16) = 0u; }
#pragma unroll 1
        for (int tile = 0; tile < NCH; ++tile) {
            int tl = tid; asm volatile("" : "+v"(tl));
            const int ln = tl & 63, lr = ln & 31, lh = ln >> 5;
            const LAS unsigned char* kt = kbuf + (tile & 1) * ATILE;
            const LAS unsigned char* vtl = vbuf + (tile & 1) * ATILE;
            const LAS unsigned char* qwl = qbuf + wave * (32 * AQ_STRIDE);
            if (tile + 1 < NCH) att_dma_tile(DK, DV, b, hd, tile + 1, kbuf + ((tile + 1) & 1) * ATILE, vbuf + ((tile + 1) & 1) * ATILE, wave, ln);
#if ATT_WARM
            {
                const int wt = tile + ATT_WARM < NCH ? tile + ATT_WARM : NCH - 1;
                const int wrow = (tl >> 2) & 63, wseg = tl & 3;
                const bf16_t* wsrc = ((tl >> 8) ? DV : DK) + (size_t)att_krow(b, wt, wrow) * DM + hd * 128 + wseg * 32;
                __builtin_amdgcn_global_load_lds((const unsigned*)wsrc, (LAS unsigned*)(lds + 4 * ATILE + 8 * 32 * AQ_STRIDE + wave * 256), 4, 0, 0);
            }
#endif
            const LAS unsigned char* kl = kt + lr * 256;
            const int kx = (lh ^ (lr & 15)) << 4;
            const int vq = (ln & 15) >> 2, vpp = ln & 3, vg1 = (ln >> 4) & 1;
            const LAS unsigned char* vl = vtl + (4 * lh + vq) * 256 + (2 * vg1 + (vpp >> 1)) * 16 + 8 * (vpp & 1);
#if ATT_ASM
            const unsigned kb0 = (unsigned)(size_t)kt + lr * 256, qb0 = (unsigned)(size_t)qwl + lr * AQ_STRIDE + lh * 16;
            const unsigned vb0 = (unsigned)(size_t)vtl + (4 * lh + vq) * 256 + (2 * vg1 + (vpp >> 1)) * 16 + 8 * (vpp & 1);
#define LDS_RD128(dst, addr, off) asm volatile("ds_read_b128 %0, %1 offset:%c2" : "=v"(dst) : "v"(addr), "n"(off))
#define LDS_RDTR(dst, addr, off) asm volatile("ds_read_b64_tr_b16 %0, %1 offset:%c2" : "=v"(dst) : "v"(addr), "n"(off))
#define LDS_WAIT3(n, a, b, c) asm volatile("s_waitcnt lgkmcnt(" #n ")" : "+v"(a), "+v"(b), "+v"(c))
#define LDS_WAIT8(n, a, b, c, d, e, f, g, h) asm volatile("s_waitcnt lgkmcnt(" #n ")" : "+v"(a), "+v"(b), "+v"(c), "+v"(d), "+v"(e), "+v"(f), "+v"(g), "+v"(h))
#define ATT_QK(c, s0, s1) do { bf16x8 k0[4], k1[4], qf[4]; \
                _Pragma("unroll") for (int ks = 0; ks < 4; ++ks) { const unsigned ka = kb0 + (((((c) * 8 + 2 * ks) << 4)) ^ kx); \
                    LDS_RD128(k0[ks], ka, 0); LDS_RD128(k1[ks], ka, 8192); LDS_RD128(qf[ks], qb0, (c) * 128 + 32 * ks); } \
                LDS_WAIT3(9, k0[0], k1[0], qf[0]); \
                s0 = __builtin_amdgcn_mfma_f32_32x32x16_bf16(k0[0], qf[0], s0, 0, 0, 0); s1 = __builtin_amdgcn_mfma_f32_32x32x16_bf16(k1[0], qf[0], s1, 0, 0, 0); \
                LDS_WAIT3(6, k0[1], k1[1], qf[1]); \
                s0 = __builtin_amdgcn_mfma_f32_32x32x16_bf16(k0[1], qf[1], s0, 0, 0, 0); s1 = __builtin_amdgcn_mfma_f32_32x32x16_bf16(k1[1], qf[1], s1, 0, 0, 0); \
                LDS_WAIT3(3, k0[2], k1[2], qf[2]); \
                s0 = __builtin_amdgcn_mfma_f32_32x32x16_bf16(k0[2], qf[2], s0, 0, 0, 0); s1 = __builtin_amdgcn_mfma_f32_32x32x16_bf16(k1[2], qf[2], s1, 0, 0, 0); \
                LDS_WAIT3(0, k0[3], k1[3], qf[3]); \
                s0 = __builtin_amdgcn_mfma_f32_32x32x16_bf16(k0[3], qf[3], s0, 0, 0, 0); s1 = __builtin_amdgcn_mfma_f32_32x32x16_bf16(k1[3], qf[3], s1, 0, 0, 0); } while (0)
#define ATT_VRD(kk, lo, hi) do { _Pragma("unroll") for (int dvb = 0; dvb < 4; ++dvb) { const unsigned va = vb0 + ((dvb ^ vq) << 6); \
                    LDS_RDTR(lo[dvb], va, (kk) * 4096); LDS_RDTR(hi[dvb], va, (kk) * 4096 + 2048); } } while (0)
#define ATT_VMM(c, kk, lo, hi, pf) do { _Pragma("unroll") for (int dvb = 0; dvb < 4; ++dvb) \
                    O[c][dvb] = __builtin_amdgcn_mfma_f32_32x32x16_bf16(cat8(lo[dvb], hi[dvb]), pf[kk], O[c][dvb], 0, 0, 0); } while (0)
#define ATT_PV(c, pf) do { s16x4 la[4], ha[4], lb[4], hb[4]; \
                ATT_VRD(0, la, ha); ATT_VRD(1, lb, hb); \
                LDS_WAIT8(8, la[0], ha[0], la[1], ha[1], la[2], ha[2], la[3], ha[3]); ATT_VMM(c, 0, la, ha, pf); \
                ATT_VRD(2, la, ha); \
                LDS_WAIT8(8, lb[0], hb[0], lb[1], hb[1], lb[2], hb[2], lb[3], hb[3]); ATT_VMM(c, 1, lb, hb, pf); \
                ATT_VRD(3, lb, hb); \
                LDS_WAIT8(8, la[0], ha[0], la[1], ha[1], la[2], ha[2], la[3], ha[3]); ATT_VMM(c, 2, la, ha, pf); \
                LDS_WAIT8(0, lb[0], hb[0], lb[1], hb[1], lb[2], hb[2], lb[3], hb[3]); ATT_VMM(c, 3, lb, hb, pf); } while (0)
#else
#define ATT_KFRAG(r0, cl) (*(const LAS bf16x8*)(kl + (r0) * 256 + ((((cl) << 4)) ^ kx)))
#define ATT_QK(c, s0, s1) do { _Pragma("unroll") for (int ks = 0; ks < 4; ++ks) { \
                const bf16x8 k0 = ATT_KFRAG(0, (c) * 8 + 2 * ks); \
                const bf16x8 k1 = ATT_KFRAG(32, (c) * 8 + 2 * ks); \
                const bf16x8 qfr = row_frag(qwl, AQ_STRIDE, 0, (c) * 64 + 16 * ks, ln); \
                s0 = __builtin_amdgcn_mfma_f32_32x32x16_bf16(k0, qfr, s0, 0, 0, 0); \
                s1 = __builtin_amdgcn_mfma_f32_32x32x16_bf16(k1, qfr, s1, 0, 0, 0); } } while (0)
#endif
#define ATT_SOFTMAX_SAFE(c, s0, s1, pf) do { \
                float ma = max3f(s0[0], s0[1], s1[0]), mb = max3f(s0[2], s0[3], s1[1]); \
                ma = max3f(ma, s1[2], s1[3]); \
                _Pragma("unroll") for (int i = 4; i < 16; i += 4) { ma = max3f(ma, s0[i], s0[i + 1]); mb = max3f(mb, s0[i + 2], s0[i + 3]); ma = max3f(ma, s1[i], s1[i + 1]); mb = max3f(mb, s1[i + 2], s1[i + 3]); } \
                float mt = max3f(ma, mb, mrun[c]); \
                { auto rr = __builtin_amdgcn_permlane32_swap(__float_as_uint(mt), __float_as_uint(mt), false, false); mt = max3f(__uint_as_float(rr[0]), __uint_as_float(rr[1]), mt); } \
                const bool grow = __any(mt > mrun[c] + 8.f);        \
                const float mnew = grow ? mt : mrun[c]; \
                float lsa = 0.f, lsb = 0.f; unsigned pk[16]; \
                _Pragma("unroll") for (int i = 0; i < 8; ++i) { \
                    const float a = __builtin_amdgcn_exp2f(s0[2 * i] - mnew), bb = __builtin_amdgcn_exp2f(s0[2 * i + 1] - mnew); \
                    lsa += a; lsb += bb; pk[i] = pk2(a, bb); \
                    const float cc = __builtin_amdgcn_exp2f(s1[2 * i] - mnew), dd = __builtin_amdgcn_exp2f(s1[2 * i + 1] - mnew); \
                    lsa += cc; lsb += dd; pk[8 + i] = pk2(cc, dd); } \
                if (grow) { \
                    const float alpha = __builtin_amdgcn_exp2f(mrun[c] - mnew); mrun[c] = mnew; lrun[c] *= alpha; \
                    _Pragma("unroll") for (int j = 0; j < 4; ++j) _Pragma("unroll") for (int i = 0; i < 16; ++i) O[c][j][i] *= alpha; } \
                lrun[c] += (lsa + lsb); \
                ATT_EXTRA_VALU(s0, s1) \
                _Pragma("unroll") for (int j = 0; j < 4; ++j) { u32x4 w; w.x = pk[4 * j]; w.y = pk[4 * j + 1]; w.z = pk[4 * j + 2]; w.w = pk[4 * j + 3]; pf[j] = __builtin_bit_cast(bf16x8, w); } } while (0)
#define ATT_SOFTMAX_FAST(c, s0, s1, pf) do { \
                float lsa = 0.f, lsb = 0.f; unsigned pk[16]; \
                _Pragma("unroll") for (int i = 0; i < 8; ++i) { \
                    const float a = __builtin_amdgcn_exp2f(s0[2 * i]), bb = __builtin_amdgcn_exp2f(s0[2 * i + 1]); \
                    lsa += a; lsb += bb; pk[i] = pk2(a, bb); \
                    const float cc = __builtin_amdgcn_exp2f(s1[2 * i]), dd = __builtin_amdgcn_exp2f(s1[2 * i + 1]); \
                    lsa += cc; lsb += dd; pk[8 + i] = pk2(cc, dd); } \
                lrun[c] += (lsa + lsb); \
                _Pragma("unroll") for (int j = 0; j < 4; ++j) { u32x4 w; w.x = pk[4 * j]; w.y = pk[4 * j + 1]; w.z = pk[4 * j + 2]; w.w = pk[4 * j + 3]; pf[j] = __builtin_bit_cast(bf16x8, w); } } while (0)
#define ATT_SOFTMAX(c, s0, s1, pf) do { if constexpr (SAFE) ATT_SOFTMAX_SAFE(c, s0, s1, pf); else ATT_SOFTMAX_FAST(c, s0, s1, pf); } while (0)
#if !ATT_ASM
#define ATT_PV(c, pf) do { _Pragma("unroll") for (int kk = 0; kk < 4; ++kk) _Pragma("unroll") for (int dvb = 0; dvb < 4; ++dvb) { \
                const LAS unsigned char* va = vl + kk * (16 * 256) + ((dvb ^ vq) << 6); \
                const bf16x8 vf = cat8(vtr(va), vtr(va + 8 * 256)); \
                O[c][dvb] = __builtin_amdgcn_mfma_f32_32x32x16_bf16(vf, pf[kk], O[c][dvb], 0, 0, 0); } } while (0)
#endif
#if ATT_SLICE
            if constexpr (!SAFE) {
#define SBAR0() __builtin_amdgcn_sched_barrier(0)
#define ATT_SGB_GROUP() do { _Pragma("unroll") for (int g_ = 0; g_ < 4; ++g_) { __builtin_amdgcn_sched_group_barrier(0x008, 1, 2); __builtin_amdgcn_sched_group_barrier(0x400, 2, 2); __builtin_amdgcn_sched_group_barrier(0x002, 2, 2); __builtin_amdgcn_sched_group_barrier(0x008, 1, 2); __builtin_amdgcn_sched_group_barrier(0x100, 2, 2); __builtin_amdgcn_sched_group_barrier(0x400, 2, 2); __builtin_amdgcn_sched_group_barrier(0x002, 1, 2); } } while (0)
#define ATT_SLICE_SM(src, base, la, lb, pf) do { u32x4 w_; \
                { const float a_ = __builtin_amdgcn_exp2f(src[(base) + 0]), b_ = __builtin_amdgcn_exp2f(src[(base) + 1]); w_.x = pk2(a_, b_); la = fadd1(la, a_, w_.x); lb = fadd1(lb, b_, w_.x); } \
                { const float a_ = __builtin_amdgcn_exp2f(src[(base) + 2]), b_ = __builtin_amdgcn_exp2f(src[(base) + 3]); w_.y = pk2(a_, b_); la = fadd1(la, a_, w_.y); lb = fadd1(lb, b_, w_.y); } \
                { const float a_ = __builtin_amdgcn_exp2f(src[(base) + 4]), b_ = __builtin_amdgcn_exp2f(src[(base) + 5]); w_.z = pk2(a_, b_); la = fadd1(la, a_, w_.z); lb = fadd1(lb, b_, w_.z); } \
                { const float a_ = __builtin_amdgcn_exp2f(src[(base) + 6]), b_ = __builtin_amdgcn_exp2f(src[(base) + 7]); w_.w = pk2(a_, b_); la = fadd1(la, a_, w_.w); lb = fadd1(lb, b_, w_.w); } \
                pf = __builtin_bit_cast(bf16x8, w_); } while (0)
#define ATT_VLOAD(kk, vf) do { _Pragma("unroll") for (int dvb = 0; dvb < 4; ++dvb) { const LAS unsigned char* va = vl + (kk) * (16 * 256) + ((dvb ^ vq) << 6); vf[dvb] = cat8(vtr(va), vtr(va + 8 * 256)); } } while (0)
#define ATT_PVG(c, vf, pf) do { _Pragma("unroll") for (int dvb = 0; dvb < 4; ++dvb) O[c][dvb] = __builtin_amdgcn_mfma_f32_32x32x16_bf16(vf[dvb], pf, O[c][dvb], 0, 0, 0); } while (0)
                f32x16 sa0, sa1, sb0, sb1;
#pragma unroll
                for (int i = 0; i < 16; ++i) { sa0[i] = 0.f; sa1[i] = 0.f; sb0[i] = 0.f; sb1[i] = 0.f; }
                float la0 = 0.f, lb0 = 0.f, la1 = 0.f, lb1 = 0.f;
                bf16x8 pcur, pnxt, vf[4];
#if ATT_SLICE == 2
                bf16x8 p1cur, p1nxt;
                ATT_QK(0, sa0, sa1);
                __builtin_amdgcn_sched_group_barrier(0x100, 12, 0);
                __builtin_amdgcn_sched_group_barrier(0x008, 8, 0);
                SBAR0();
                ATT_QK(1, sb0, sb1);
                ATT_SLICE_SM(sa0, 0, la0, lb0, pcur);
                __builtin_amdgcn_sched_group_barrier(0x100, 12, 1);
#pragma unroll
                for (int g_ = 0; g_ < 8; ++g_) { __builtin_amdgcn_sched_group_barrier(0x008, 1, 1); __builtin_amdgcn_sched_group_barrier(0x002, 3, 1); }
                SBAR0();
                ATT_VLOAD(0, vf);
                ATT_SLICE_SM(sb0, 0, la1, lb1, p1cur);
                SBAR0();
                ATT_PVG(0, vf, pcur); ATT_PVG(1, vf, p1cur); ATT_VLOAD(1, vf); ATT_SLICE_SM(sa0, 8, la0, lb0, pnxt); ATT_SLICE_SM(sb0, 8, la1, lb1, p1nxt); ATT_SGB_GROUP(); SBAR0();
                ATT_PVG(0, vf, pnxt); ATT_PVG(1, vf, p1nxt); ATT_VLOAD(2, vf); ATT_SLICE_SM(sa1, 0, la0, lb0, pcur); ATT_SLICE_SM(sb1, 0, la1, lb1, p1cur); ATT_SGB_GROUP(); SBAR0();
                ATT_PVG(0, vf, pcur); ATT_PVG(1, vf, p1cur); ATT_VLOAD(3, vf); ATT_SLICE_SM(sa1, 8, la0, lb0, pnxt); ATT_SLICE_SM(sb1, 8, la1, lb1, p1nxt); ATT_SGB_GROUP(); SBAR0();
                ATT_PVG(0, vf, pnxt); ATT_PVG(1, vf, p1nxt); SBAR0();
#else
                ATT_QK(0, sa0, sa1);
                SBAR0();
                ATT_QK(1, sb0, sb1);
                ATT_SLICE_SM(sa0, 0, la0, lb0, pcur);
                SBAR0();
                ATT_VLOAD(0, vf);
                ATT_PVG(0, vf, pcur); SBAR0(); ATT_VLOAD(1, vf); ATT_SLICE_SM(sa0, 8, la0, lb0, pnxt); SBAR0();
                ATT_PVG(0, vf, pnxt); SBAR0(); ATT_VLOAD(2, vf); ATT_SLICE_SM(sa1, 0, la0, lb0, pcur); SBAR0();
                ATT_PVG(0, vf, pcur); SBAR0(); ATT_VLOAD(3, vf); ATT_SLICE_SM(sa1, 8, la0, lb0, pnxt); SBAR0();
                ATT_PVG(0, vf, pnxt); SBAR0(); ATT_VLOAD(0, vf); ATT_SLICE_SM(sb0, 0, la1, lb1, pcur); SBAR0();
                ATT_PVG(1, vf, pcur); SBAR0(); ATT_VLOAD(1, vf); ATT_SLICE_SM(sb0, 8, la1, lb1, pnxt); SBAR0();
                ATT_PVG(1, vf, pnxt); SBAR0(); ATT_VLOAD(2, vf); ATT_SLICE_SM(sb1, 0, la1, lb1, pcur); SBAR0();
                ATT_PVG(1, vf, pcur); SBAR0(); ATT_VLOAD(3, vf); ATT_SLICE_SM(sb1, 8, la1, lb1, pnxt); SBAR0();
                ATT_PVG(1, vf, pnxt); SBAR0();
#endif
                lrun[0] += la0 + lb0; lrun[1] += la1 + lb1;
#undef SBAR0
#undef ATT_SGB_GROUP
#undef ATT_SLICE_SM
#undef ATT_VLOAD
#undef ATT_PVG
            } else
#endif
            {
                f32x16 sa0, sa1, sb0, sb1;
#pragma unroll
                for (int i = 0; i < 16; ++i) { sa0[i] = 0.f; sa1[i] = 0.f; sb0[i] = 0.f; sb1[i] = 0.f; }
                bf16x8 pfa[4], pfb[4];
                ATT_QK(0, sa0, sa1);
                if constexpr (!SAFE) __builtin_amdgcn_sched_barrier(0);
#if ATT_PLAN == 1
                ATT_QK(1, sb0, sb1);
                ATT_SOFTMAX(0, sa0, sa1, pfa);
#else
                ATT_SOFTMAX(0, sa0, sa1, pfa);
                if constexpr (!SAFE) __builtin_amdgcn_sched_barrier(0);
                ATT_QK(1, sb0, sb1);
#endif
                if constexpr (!SAFE) __builtin_amdgcn_sched_barrier(0);
                ATT_PV(0, pfa);
                ATT_SOFTMAX(1, sb0, sb1, pfb);
#if ATT_FENCE3
                if constexpr (!SAFE) __builtin_amdgcn_sched_barrier(0);
#endif
                ATT_PV(1, pfb);
                if constexpr (!SAFE) __builtin_amdgcn_sched_barrier(0);
            }
#ifdef ATT_KFRAG
#undef ATT_KFRAG
#endif
#undef ATT_QK
#undef ATT_SOFTMAX
#undef ATT_SOFTMAX_SAFE
#undef ATT_SOFTMAX_FAST
#undef ATT_PV
#if ATT_WARM
            asm volatile("s_waitcnt vmcnt(1) lgkmcnt(0)" ::: "memory");
            __builtin_amdgcn_s_barrier();
            asm volatile("" ::: "memory");
#else
            asm volatile("s_waitcnt vmcnt(0)" ::: "memory");
            __syncthreads();
#endif
        }
#if ATT_WARM
        asm volatile("s_waitcnt vmcnt(0)" ::: "memory");
#endif
        float l0, l1; { auto r0 = __builtin_amdgcn_permlane32_swap(__float_as_uint(lrun[0]), __float_as_uint(lrun[0]), false, false); l0 = __uint_as_float(r0[0]) + __uint_as_float(r0[1]);
          auto r1 = __builtin_amdgcn_permlane32_swap(__float_as_uint(lrun[1]), __float_as_uint(lrun[1]), false, false); l1 = __uint_as_float(r1[0]) + __uint_as_float(r1[1]); }
        if constexpr (!SAFE) {
            const bool bad = !(l0 > 1e-30f && l0 < 1e30f && l1 > 1e-30f && l1 < 1e30f);
            volatile LAS unsigned* badflag = (volatile LAS unsigned*)(lds + LDS_BARST + 16);
            if (bad) *badflag = 1u;
            __syncthreads();
            if (*badflag != 0u) return true;
        }
        const float i0 = 1.f / l0, i1 = lam / l1;
        float ss = 0.f;
#pragma unroll
        for (int j = 0; j < 4; ++j)
#pragma unroll
            for (int i = 0; i < 16; ++i) { const float o = O[0][j][i] * i0 - O[1][j][i] * i1; O[0][j][i] = o; ss += o * o; }
        { auto r0 = __builtin_amdgcn_permlane32_swap(__float_as_uint(ss), __float_as_uint(ss), false, false); ss = __uint_as_float(r0[0]) + __uint_as_float(r0[1]); }
        const float rn = rsqrtf(ss * (1.f / 128.f) + EPSN) * (1.f - LAM_INIT);
        int lnf = lane; asm volatile("" : "+v"(lnf));
        const int hif = lnf >> 5;
        bf16_t* orow = (bf16_t*)(ws + WS_H) + (size_t)(b * SEQL + qb * 256 + wave * 32 + (lnf & 31)) * DM + hd * 128;
        const float* gn = p.in[16] + hd * 128;
#pragma unroll
        for (int j = 0; j < 4; ++j)
#pragma unroll
            for (int g = 0; g < 4; ++g) {
                const int dv = 32 * j + 8 * g + 4 * hif;
                const f32x4 gg = *(const f32x4*)(gn + dv);
                u32x2 w; w.x = pk2(O[0][j][4 * g] * rn * gg.x, O[0][j][4 * g + 1] * rn * gg.y); w.y = pk2(O[0][j][4 * g + 2] * rn * gg.z, O[0][j][4 * g + 3] * rn * gg.w);
                *(u32x2*)(orow + dv) = w;
            }
    return false;
}

__device__ __forceinline__ void phase_attn(const Params& p, LAS unsigned char* lds) {
    const int tid = threadIdx.x, lane = tid & 63, wave = __builtin_amdgcn_readfirstlane(tid >> 6), r32 = lane & 31, hi = lane >> 5;
    unsigned char* ws = p.ws;
    const bf16_t* DQ = (const bf16_t*)(ws + R_DQ); const bf16_t* DK = (const bf16_t*)(ws + R_DK); const bf16_t* DV = (const bf16_t*)(ws + R_DV);
    const float lam = *(const float*)(ws + CTL_LAM);
    LAS unsigned char* kbuf = lds;
    LAS unsigned char* vbuf = lds + 2 * ATILE;
    LAS unsigned char* qbuf = lds + 4 * ATILE;
    static_assert(4 * ATILE + 8 * 32 * AQ_STRIDE + 2048 <= LDS_BARST, "attention LDS");
    const int G = gridDim.x;
    const int nunits = NB * 8 * 32;
#define ATT_UNIT_INDEX(ui, b, hd, qb, stop) do { stop = false; \
        if (G == 256) { if (ui >= 4) { stop = true; b = hd = qb = 0; } else { const int bh = ui * 8 + (blockIdx.x & 7); b = bh >> 3; hd = bh & 7; qb = blockIdx.x >> 3; } }     \
        else { const int it = ui * G + blockIdx.x; if (it >= nunits) { stop = true; b = hd = qb = 0; } else { b = it >> 8; hd = (it >> 5) & 7; qb = it & 31; } } } while (0)
#if ATT_FAST
    unsigned badmask = 0u;
    for (int ui = 0; ui < 32; ++ui) {
        int b, hd, qb; bool stop; ATT_UNIT_INDEX(ui, b, hd, qb, stop); if (stop) break;
        if (att_unit<false>(p, lds, b, hd, qb)) badmask |= 1u << ui;
    }
    if (badmask) {
        for (int ui = 0; ui < 32; ++ui) {
            int b, hd, qb; bool stop; ATT_UNIT_INDEX(ui, b, hd, qb, stop); if (stop) break;
#ifndef ATT_NOFALLBACK
            if ((badmask >> ui) & 1u) { __syncthreads(); att_unit<true>(p, lds, b, hd, qb); }
#endif
        }
    }
#else
    for (int ui = 0;; ++ui) {
        int b, hd, qb; bool stop; ATT_UNIT_INDEX(ui, b, hd, qb, stop); if (stop) break;
        att_unit<true>(p, lds, b, hd, qb);
    }
#endif
#undef ATT_UNIT_INDEX
}

#define XB_TMO      128
#define XB_XCNT(j)  (256  + 64 * (j))
#define XB_XSUB(j)  (1280 + 64 * (j))
#define XB_XGEN(j)  (2304 + 64 * (j))
#define XB_TOP      3328
#define XB_TOPGEN   3392
#define XCD_BAR_WORDS 3456
#define XB_SPIN_CAP (1u << 18)

__device__ __forceinline__ unsigned xb_ld(unsigned* p)              { return __hip_atomic_load(p, __ATOMIC_RELAXED, __HIP_MEMORY_SCOPE_AGENT); }
__device__ __forceinline__ unsigned xb_add(unsigned* p, unsigned v) { return __hip_atomic_fetch_add(p, v, __ATOMIC_RELAXED, __HIP_MEMORY_SCOPE_AGENT); }
__device__ __forceinline__ unsigned xb_xcc_id() { return (unsigned)__builtin_amdgcn_s_getreg((3 << 11) | 20) & 0xFu; }
#define XB_SPIN(cond, bar) do { unsigned _sp = 0; while (cond) { __builtin_amdgcn_s_sleep(1); \
    if ((++_sp & 255u) == 0u) { if (xb_ld(&(bar)[XB_TMO])) break; if (_sp > XB_SPIN_CAP) { atomicAdd(&(bar)[XB_TMO], 1u); break; } } } } while (0)

struct XcdBarrier {
    unsigned* bar; unsigned x;
    volatile LAS unsigned* st;
};

__device__ __forceinline__ XcdBarrier xcd_barrier_post(unsigned* bar, volatile LAS unsigned* st) {
    XcdBarrier b; b.bar = bar; b.x = xb_xcc_id(); b.st = st;
    if (threadIdx.x == 0) (void)xb_add(&bar[XB_XCNT(b.x)], 1u);
    return b;
}
__device__ __forceinline__ void xcd_barrier_complete(unsigned* bar, unsigned x, unsigned& nloc, unsigned& nx) {
    const unsigned G = gridDim.x * gridDim.y * gridDim.z;
    unsigned sum, cnt, mine, sp = 0u;
    for (;;) {
        sum = 0u; cnt = 0u; mine = 0u;
#pragma unroll
        for (unsigned j = 0; j < 16; ++j) { const unsigned c = xb_ld(&bar[XB_XCNT(j)]); sum += c; cnt += (c > 0u) ? 1u : 0u; mine = (j == x) ? c : mine; }
        if (sum == G) break;
        __builtin_amdgcn_s_sleep(1);
        if ((++sp & 255u) == 0u) { if (xb_ld(&bar[XB_TMO])) break; if (sp > XB_SPIN_CAP) { atomicAdd(&bar[XB_TMO], 1u); break; } }
    }
    nloc = mine > 0u ? mine : 1u; nx = cnt > 0u ? cnt : 1u;
}

__device__ __forceinline__ void xcd_barrier(const XcdBarrier& b) {
    asm volatile("s_waitcnt vmcnt(0)" ::: "memory");
    __syncthreads();
    if (threadIdx.x == 0) {
        unsigned* bar = b.bar;
        __builtin_amdgcn_s_waitcnt(0);
        unsigned nloc = b.st[0], nx = b.st[1];
        if (nloc == 0u) { xcd_barrier_complete(bar, b.x, nloc, nx); b.st[0] = nloc; b.st[1] = nx; }
        const unsigned old = xb_add(&bar[XB_XSUB(b.x)], 1u);
        const unsigned gen = old / nloc;
        if (old + 1u == (gen + 1u) * nloc) {
            __builtin_amdgcn_fence(__ATOMIC_RELEASE, "agent");
            asm volatile("s_waitcnt vmcnt(0)" ::: "memory");
            const unsigned og = xb_add(&bar[XB_TOP], 1u);
            const unsigned tg = og / nx;
            if (og + 1u == (tg + 1u) * nx) xb_add(&bar[XB_TOPGEN], 1u);
            else XB_SPIN(xb_ld(&bar[XB_TOPGEN]) == tg, bar);
            __builtin_amdgcn_fence(__ATOMIC_ACQUIRE, "agent");
            xb_add(&bar[XB_XGEN(b.x)], 1u);
            asm volatile("s_waitcnt vmcnt(0)" ::: "memory");
        } else {
            XB_SPIN(xb_ld(&bar[XB_XGEN(b.x)]) == gen, bar);
            __builtin_amdgcn_fence(__ATOMIC_ACQUIRE, "agent");
            asm volatile("s_waitcnt vmcnt(0)" ::: "memory");
        }
    }
    __syncthreads();
}

constexpr int NPHASES = 21;
struct DownOrder {
    static constexpr bool SPLITK = true;
    pg8::StaticOrder lat; int G, c;
    __device__ void init(int G_, int c_) { lat.init(LROWS, DM, G_, c_); G = G_; c = c_; }
    __device__ bool next(int i, pg8::Unit& u) const {
        const long L = (long)i * G + c;
        if (L < 512) { lat.next(i, u); u.kb = 0; u.nt = DFF / 64; return true; }
        const int j = (int)L - 512; if (j >= 176) return false;
        const int tile = j / 11, ks = j % 11;
        u.pm = LROWS / 256 + (tile >> 2); u.pn = tile & 3; u.kb = ks * 4; u.nt = 4; return true;
    }
    __device__ __forceinline__ void a_ready(const pg8::Unit&) const {}
    __device__ __forceinline__ void done(const pg8::Unit&) const {}
};
__device__ __forceinline__ void run_gemm_down1(LAS unsigned char* lds, const Params& p, const bf16_t* A, const bf16_t* Bt) {
    __syncthreads();
    pg8::Gemm g{A, Bt, MROWS, DM, DFF};
    Epi<EPI_RESID_SPLIT> E{}; E.gate_i = 2; E.gscale = 0.5f; E.wsp = p.ws; E.outp = p.out; E.xp = p.in[0]; E.ctxp = p.in[2];
    DownOrder S; S.init((int)gridDim.x, (int)blockIdx.x);
    pg8::gemm_phase<Epi<EPI_RESID_SPLIT>, DownOrder, true, true>(lds, g, S, E);
}
template <int MODE>
__device__ __forceinline__ void run_gemm(LAS unsigned char* lds, const Params& p, const bf16_t* A, const bf16_t* Bt, int M, int N, int K, int gate_i, float gscale) {
    __syncthreads();
    pg8::Gemm g{A, Bt, M, N, K};
    Epi<MODE> E{}; E.gate_i = gate_i; E.gscale = gscale; E.wsp = p.ws; E.outp = p.out; E.xp = p.in[0]; E.ctxp = p.in[2];
    pg8::StaticOrder S; S.init(M, N, (int)gridDim.x, (int)blockIdx.x);
    pg8::gemm_phase<Epi<MODE>, pg8::StaticOrder, true, true>(lds, g, S, E);
}
__global__ void __launch_bounds__(512, 2) fwd_megakernel(Params p) {
    extern __shared__ __attribute__((aligned(16))) unsigned char lds_raw[];
    LAS unsigned char* lds = (LAS unsigned char*)lds_raw;
    unsigned char* ws = p.ws;
    const float* MOD = (const float*)(ws + CTL_MOD);
    bf16_t* H = (bf16_t*)(ws + WS_H);
    const int lo = p.ph_lo, hi = p.ph_hi;
#define IN(k) (lo <= (k) && (k) < hi)
    volatile LAS unsigned* bst = (volatile LAS unsigned*)(lds + LDS_BARST);
    if (threadIdx.x == 0) { bst[0] = 0u; bst[1] = 0u; }
    __syncthreads();
    XcdBarrier xb; xb.bar = (unsigned*)(ws + CTL_BAR); xb.x = 0; xb.st = bst;
    if (hi - lo > 1) xb = xcd_barrier_post((unsigned*)(ws + CTL_BAR), bst);
#define SEAM(k) do { if (IN(k) && IN((k) + 1)) { if (SEAM0_CG && (k) == 0) cg::this_grid().sync(); else xcd_barrier(xb); } } while (0)
    if (lo > 1000) cg::this_grid().sync();
#ifndef NO_PREP
    if (IN(0)) phase_prep(p, lds);
#endif
    SEAM(0);
    if (IN(1)) { phase_modnorm(p.in[0], p.in[2], MROWS, p.in[6], MOD, 0, 1, H); phase_wcopy(p, lds); }
    SEAM(1);
#ifndef NO_GEMM
    if (IN(2)) run_gemm<EPI_SWIGLU>(lds, p, H, (const bf16_t*)(ws + W_W13A), MROWS, 2 * DFF, DM, 0, 0.f);
    SEAM(2);
#if SPLITK_DOWN1
    if (IN(3)) run_gemm_down1(lds, p, (const bf16_t*)(ws + R_U), (const bf16_t*)(ws + W_W2A));
#else
    if (IN(3)) run_gemm<EPI_RESID>(lds, p, (const bf16_t*)(ws + R_U), (const bf16_t*)(ws + W_W2A), MROWS, DM, DFF, 2, 0.5f);
#endif
#endif
    SEAM(3);
#if SPLITK_DOWN1
    if (IN(4)) phase_modnorm(p.out, p.in[2], MROWS, p.in[10], MOD, 3, 4, H, (const float*)(ws + WS_R + R_PART_OFF * MiB));
#else
    if (IN(4)) phase_modnorm(p.out, (const float*)(ws + R_XC1), MROWS, p.in[10], MOD, 3, 4, H);
#endif
    SEAM(4);
#ifndef NO_GEMM
    if (IN(5)) run_gemm<EPI_WINA>(lds, p, H, (const bf16_t*)(ws + W_WINA), MROWS, NWIN_A, DM, 0, 0.f);
#endif
    SEAM(5);
#ifndef NO_GLAA
    if (IN(6)) phase_gla_a(p, lds, 0);
#endif
    SEAM(6);
#ifndef NO_SCAN
    if (IN(7)) phase_gla_scan(p);
#endif
    SEAM(7);
#ifndef NO_GLAC
    if (IN(8)) phase_gla_c(p, lds, 0);
#endif
    SEAM(8);
#ifndef NO_GLAA
    if (IN(9)) phase_gla_a(p, lds, 1);
#endif
    SEAM(9);
#ifndef NO_SCAN
    if (IN(10)) phase_gla_scan(p);
#endif
    SEAM(10);
#ifndef NO_GLAC
    if (IN(11)) phase_gla_c(p, lds, 1);
#endif
    SEAM(11);
#ifndef NO_GEMM
    if (IN(12)) run_gemm<EPI_WINB>(lds, p, H, (const bf16_t*)(ws + W_WINB), MROWS, NWIN_B, DM, 0, 0.f);
#endif
    SEAM(12);
#ifndef NO_ATTN
    if (IN(13)) phase_attn(p, lds);
#endif
    SEAM(13);
#ifndef NO_GEMM
    if (IN(14)) run_gemm<EPI_MERGE1>(lds, p, (const bf16_t*)(ws + WS_GG), (const bf16_t*)(ws + W_WBG), LROWS, DM, DM, 0, 0.f);
    SEAM(14);
    if (IN(15)) run_gemm<EPI_MERGE2>(lds, p, (const bf16_t*)(ws + WS_H), (const bf16_t*)(ws + W_WBD), LROWS, DM, DM, 0, 0.f);
    SEAM(15);
    if (IN(16)) run_gemm<EPI_RESID>(lds, p, (const bf16_t*)(ws + R_GA), (const bf16_t*)(ws + W_WOUT), LROWS, DM, DM, 5, 1.0f);
#endif
    SEAM(16);
    if (IN(17)) phase_modnorm(p.out, p.out, LROWS, p.in[20], MOD, 6, 7, H);
    SEAM(17);
#ifndef NO_GEMM
    if (IN(18)) run_gemm<EPI_SWIGLU>(lds, p, H, (const bf16_t*)(ws + W_W13B), LROWS, 2 * DFF, DM, 0, 0.f);
    SEAM(18);
    if (IN(19)) run_gemm<EPI_RESID>(lds, p, (const bf16_t*)(ws + R_U), (const bf16_t*)(ws + W_W2B), LROWS, DM, DFF, 8, 0.5f);
#endif
    SEAM(19);
    if (IN(20)) phase_finalnorm(p.out, p.in[24]);
#ifdef MK_GLA_PROBE
    if (IN(106)) phase_gla_a(p, lds, 0);
    if (IN(107)) phase_gla_scan(p);
    if (IN(108)) phase_gla_c(p, lds, 0, true);
#endif
#ifdef MK_DUMPF
    if (IN(100)) { const float* src = (const float*)(ws + (MK_DUMPF)); for (size_t i = (size_t)blockIdx.x * 512 + threadIdx.x; i < (size_t)LROWS * DM; i += (size_t)gridDim.x * 512) p.out[i] = src[i % (size_t)(MK_DUMPF_N)]; }
#elif defined(MK_DUMP)
    if (IN(100)) { const bf16_t* src = (const bf16_t*)(ws + (MK_DUMP)); for (size_t i = (size_t)blockIdx.x * 512 + threadIdx.x; i < (size_t)LROWS * DM; i += (size_t)gridDim.x * 512) p.out[i] = bf2f(src[i]); }
#endif
#undef IN
#undef SEAM
}

#ifndef MK_ONE_LAUNCH
#define MK_ONE_LAUNCH 0
#endif
#ifndef MK_REP_N
#define MK_REP_N 1
#endif
#ifndef MK_REP_PH2
#define MK_REP_PH2 -1
#endif
extern "C" void kernel_launch(void* const* d_in, const int* in_sizes, int n_in, void* d_out, int out_size, void* d_ws, size_t ws_size, hipStream_t stream) {
    static int grid = 0;
    if (grid == 0) {
        if (n_in != 25 || out_size != LROWS * DM || ws_size < WS_END) { fprintf(stderr, "kernel_launch: unexpected problem (n_in %d out %d ws %zu, need ws >= %zu); nothing launched\n", n_in, out_size, ws_size, (size_t)WS_END); grid = -1; return; }
        int dev = 0, cus = 0, per_cu = 0;
        if (hipGetDevice(&dev) != hipSuccess || hipDeviceGetAttribute(&cus, hipDeviceAttributeMultiprocessorCount, dev) != hipSuccess) { fprintf(stderr, "kernel_launch: device query failed\n"); grid = -1; return; }
        if (hipFuncSetAttribute((const void*)fwd_megakernel, hipFuncAttributeMaxDynamicSharedMemorySize, LDS_BYTES) != hipSuccess) { fprintf(stderr, "kernel_launch: hipFuncSetAttribute failed\n"); grid = -1; return; }
        if (hipOccupancyMaxActiveBlocksPerMultiprocessor(&per_cu, (const void*)fwd_megakernel, 512, LDS_BYTES) != hipSuccess || per_cu < 1) { fprintf(stderr, "kernel_launch: occupancy query says %d blocks per CU\n", per_cu); per_cu = 1; }
        (void)hipGetLastError();
        grid = cus * (per_cu > 1 ? 1 : per_cu);
        fprintf(stderr, "kernel_launch: grid %d (cus %d, per_cu %d), ws %zu\n", grid, cus, per_cu, ws_size);
    }
    if (grid < 0) return;
#if MK_ONE_LAUNCH
    if (hipMemsetAsync((char*)d_ws + CTL_BAR, 0, 16384, stream) != hipSuccess) { fprintf(stderr, "kernel_launch: memset failed\n"); return; }
#endif
    Params p{};
    for (int i = 0; i < 25; ++i) p.in[i] = (const float*)d_in[i];
    p.out = (float*)d_out; p.ws = (unsigned char*)d_ws;
#if MK_ONE_LAUNCH
    p.ph_lo = 0; p.ph_hi = NPHASES;
    void* args[] = {&p};
    hipError_t e = hipLaunchCooperativeKernel((const void*)fwd_megakernel, dim3(grid), dim3(512), args, LDS_BYTES, stream);
    if (e != hipSuccess) fprintf(stderr, "kernel_launch: cooperative launch failed: %s (grid %d)\n", hipGetErrorString(e), grid);
#else
#ifndef MK_STOP_AFTER
#define MK_STOP_AFTER (NPHASES - 1)
#endif
    for (int ph = 0; ph <= MK_STOP_AFTER; ++ph) {
#ifdef MK_SKIP_LO
        if (ph >= MK_SKIP_LO && ph <= MK_SKIP_HI) continue;
#endif
#ifdef MK_GLA_PROBE
        if (ph == 6) for (int r = 0; r < MK_GLA_PROBE; ++r) for (int q = 106; q <= 108; ++q) { p.ph_lo = q; p.ph_hi = q + 1; hipLaunchKernelGGL(fwd_megakernel, dim3(grid), dim3(512), LDS_BYTES, stream, p); }
#endif
        p.ph_lo = ph; p.ph_hi = ph + 1;
        hipLaunchKernelGGL(fwd_megakernel, dim3(grid), dim3(512), LDS_BYTES, stream, p);
#ifdef MK_REP_PH
        if (ph == MK_REP_PH || ph == MK_REP_PH2) for (int r = 0; r < MK_REP_N; ++r) hipLaunchKernelGGL(fwd_megakernel, dim3(grid), dim3(512), LDS_BYTES, stream, p);
#endif
    }
#if defined(MK_DUMP) || defined(MK_DUMPF)
    { p.ph_lo = 100; p.ph_hi = 101; hipLaunchKernelGGL(fwd_megakernel, dim3(grid), dim3(512), LDS_BYTES, stream, p); }
#endif
#endif
}
```
